# Optimizing an MI355X kernel written in HIP

```python
import math
import jax
import jax.numpy as jnp
from jax import lax
import numpy as np


D_MODEL = 2048
BATCH = 2
SEQ = 4096
DEPTH = 4
DEC_BATCH = 4
DEC_SEQ = 2048
PAST_LEN = 128

HEAD_DIM = 128
BLOCK = 128
A_HEADS = 4
A_V = 2 * HEAD_DIM
B_HEADS = 8
B_KV_HEADS = 2
WINDOW = 128
C_HEADS = 8
C_KV_HEADS = 2
GRID_W = 64
ROPE_THETA = 10000.0
NUM_BUCKETS = 32
MAX_DISTANCE = 128
BIAS_HEADS = A_HEADS + B_HEADS
MEM_TOKENS = 256
MEM_HEADS = 4
MEM_INNER = MEM_HEADS * HEAD_DIM
D_FF = 5632
N_BRANCH = 3
BRANCH_WIDTH = 1024
IN_SIZES = (A_HEADS * 2 * HEAD_DIM, A_HEADS * 2 * HEAD_DIM, A_HEADS * A_V,
            B_HEADS * HEAD_DIM, B_KV_HEADS * HEAD_DIM, B_KV_HEADS * HEAD_DIM,
            C_HEADS * HEAD_DIM, C_KV_HEADS * HEAD_DIM, C_KV_HEADS * HEAD_DIM,
            N_BRANCH * D_MODEL)
IN_WIDTH = 12288
ALPHA = (2 * DEPTH) ** 0.25
BETA = (8 * DEPTH) ** -0.25
LN_EPS = 1e-5
RMS_EPS = 1e-6
NEG_INF = -1e30

kernel_name = 'hybrid_gated_encoder_trunk'


def _split_points(sizes):
    pts, acc = [], 0
    for s in sizes[:-1]:
        acc += s
        pts.append(acc)
    return pts


def layer_norm(x, g, b):
    xf = x.astype(jnp.float32)
    mu = jnp.mean(xf, axis=-1, keepdims=True)
    var = jnp.mean(jnp.square(xf - mu), axis=-1, keepdims=True)
    return ((xf - mu) * lax.rsqrt(var + LN_EPS) * g.astype(jnp.float32) + b.astype(jnp.float32)).astype(x.dtype)


def rms_norm(x, g):
    xf = x.astype(jnp.float32)
    return (xf * lax.rsqrt(jnp.mean(xf * xf, axis=-1, keepdims=True) + RMS_EPS) * g.astype(jnp.float32)).astype(x.dtype)


def t5_bucket(rel):
    half = NUM_BUCKETS // 2
    max_exact = half // 2
    ret = jnp.where(rel > 0, half, 0)
    n = jnp.abs(rel)
    large = max_exact + (jnp.log(jnp.maximum(n, 1).astype(jnp.float32) / max_exact)
                         / math.log(MAX_DISTANCE / max_exact) * (half - max_exact)).astype(jnp.int32)
    large = jnp.minimum(large, half - 1)
    return ret + jnp.where(n < max_exact, n, large)


def axial_rope_tables(S):
    n_rows = S // GRID_W
    row = jnp.broadcast_to(jnp.arange(n_rows)[:, None], (n_rows, GRID_W)).reshape(-1).astype(jnp.float32)
    col = jnp.broadcast_to(jnp.arange(GRID_W)[None, :], (n_rows, GRID_W)).reshape(-1).astype(jnp.float32)
    axis_dims = HEAD_DIM // 2
    inv = ROPE_THETA ** (-jnp.arange(0, axis_dims, 2, dtype=jnp.float32) / axis_dims)
    ang = jnp.concatenate([row[:, None] * inv[None, :], col[:, None] * inv[None, :]], axis=-1)
    return jnp.cos(ang), jnp.sin(ang)


def apply_rope(x, cos, sin):
    half = HEAD_DIM // 2
    x1, x2 = x[..., :half], x[..., half:]
    c = cos[None, :, None, :]
    s = sin[None, :, None, :]
    return jnp.concatenate([x1 * c - x2 * s, x1 * s + x2 * c], axis=-1).astype(x.dtype)


def swiglu(x, w_gu, w_d):
    g, u = jnp.split(x @ w_gu, 2, axis=-1)
    return (jax.nn.silu(g) * u) @ w_d


def diff_attention(q, k, v, lam, subln_g, table_a, lambda_init):
    B, S = q.shape[0], q.shape[1]
    nb = S // BLOCK
    scale = HEAD_DIM ** -0.5
    lamf = lam.astype(jnp.float32)
    lam_full = jnp.exp(jnp.sum(lamf[0] * lamf[1])) - jnp.exp(jnp.sum(lamf[2] * lamf[3])) + lambda_init
    k_pos = jnp.arange(S)
    qb = jnp.moveaxis(q.reshape(B, nb, BLOCK, A_HEADS, 2, HEAD_DIM), 1, 0)

    def block(args):
        qi, i = args
        q_pos = i * BLOCK + jnp.arange(BLOCK)
        bias = jnp.moveaxis(table_a[t5_bucket(k_pos[None, :] - q_pos[:, None])], -1, 0)
        s = jnp.einsum('bqhmd,bshmd->bhmqs', qi, k).astype(jnp.float32) * scale
        p = jax.nn.softmax(s + bias[None, :, None].astype(jnp.float32), axis=-1)
        attn = p[:, :, 0] - lam_full * p[:, :, 1]
        return jnp.einsum('bhqs,bshe->bqhe', attn.astype(v.dtype), v)

    o = lax.map(block, (qb, jnp.arange(nb)))
    o = jnp.moveaxis(o, 0, 1).reshape(B, S, A_HEADS, A_V)
    o = rms_norm(o, subln_g) * (1.0 - lambda_init)
    return o.reshape(B, S, A_HEADS * A_V)


def window_attention(q, k, v, sink, table_b):
    B, S = q.shape[0], q.shape[1]
    nb = S // BLOCK
    G = B_HEADS // B_KV_HEADS
    scale = HEAD_DIM ** -0.5
    pad = ((0, 0), (BLOCK, BLOCK), (0, 0), (0, 0))
    kp = jnp.pad(k, pad).reshape(B, nb + 2, BLOCK, B_KV_HEADS, HEAD_DIM)
    vp = jnp.pad(v, pad).reshape(B, nb + 2, BLOCK, B_KV_HEADS, HEAD_DIM)
    kw = jnp.concatenate([kp[:, :-2], kp[:, 1:-1], kp[:, 2:]], axis=2)
    vw = jnp.concatenate([vp[:, :-2], vp[:, 1:-1], vp[:, 2:]], axis=2)
    qb = q.reshape(B, nb, BLOCK, B_KV_HEADS, G, HEAD_DIM)
    s = jnp.einsum('bnqhgd,bnkhd->bnhgqk', qb, kw).astype(jnp.float32) * scale
    q_off = jnp.arange(BLOCK)
    k_off = jnp.arange(3 * BLOCK) - BLOCK
    rel = k_off[None, :] - q_off[:, None]
    k_abs = jnp.arange(nb)[:, None] * BLOCK + k_off[None, :]
    valid = (jnp.abs(rel) <= WINDOW)[None] & ((k_abs >= 0) & (k_abs < S))[:, None, :]
    bias = jnp.moveaxis(table_b[t5_bucket(rel)], -1, 0).reshape(B_KV_HEADS, G, BLOCK, 3 * BLOCK)
    s = jnp.where(valid[None, :, None, None], s + bias.astype(jnp.float32), NEG_INF)
    sink_l = jnp.broadcast_to(sink.reshape(B_KV_HEADS, G)[None, None, :, :, None, None].astype(jnp.float32),
                              s.shape[:-1] + (1,))
    p = jax.nn.softmax(jnp.concatenate([s, sink_l], axis=-1), axis=-1)[..., :-1]
    o = jnp.einsum('bnhgqk,bnkhd->bnqhgd', p.astype(v.dtype), vw)
    return o.reshape(B, S, B_HEADS * HEAD_DIM)


def axial_attention(q, k, v, q_g, k_g, cos, sin):
    B, S = q.shape[0], q.shape[1]
    nb = S // BLOCK
    G = C_HEADS // C_KV_HEADS
    scale = HEAD_DIM ** -0.5
    q = apply_rope(rms_norm(q, q_g), cos, sin)
    k = apply_rope(rms_norm(k, k_g), cos, sin)
    qb = jnp.moveaxis(q.reshape(B, nb, BLOCK, C_KV_HEADS, G, HEAD_DIM), 1, 0)

    def block(qi):
        s = jnp.einsum('bqhgd,bshd->bhgqs', qi, k).astype(jnp.float32) * scale
        p = jax.nn.softmax(s, axis=-1)
        return jnp.einsum('bhgqs,bshd->bqhgd', p.astype(v.dtype), v)

    o = lax.map(block, qb)
    return jnp.moveaxis(o, 0, 1).reshape(B, S, C_HEADS * HEAD_DIM)


def parallel_mixer(x, w_in, w_branch, w_out, lam, subln_g, sink, qk_g, rel_bias_table, lambda_init, cos, sin):
    B, S, _ = x.shape
    parts = jnp.split(x @ w_in, _split_points(IN_SIZES), axis=-1)
    qa = parts[0].reshape(B, S, A_HEADS, 2, HEAD_DIM)
    ka = parts[1].reshape(B, S, A_HEADS, 2, HEAD_DIM)
    va = parts[2].reshape(B, S, A_HEADS, A_V)
    qb = parts[3].reshape(B, S, B_HEADS, HEAD_DIM)
    kb = parts[4].reshape(B, S, B_KV_HEADS, HEAD_DIM)
    vb = parts[5].reshape(B, S, B_KV_HEADS, HEAD_DIM)
    qc = parts[6].reshape(B, S, C_HEADS, HEAD_DIM)
    kc = parts[7].reshape(B, S, C_KV_HEADS, HEAD_DIM)
    vc = parts[8].reshape(B, S, C_KV_HEADS, HEAD_DIM)
    gates = jax.nn.sigmoid(parts[9].reshape(B, S, N_BRANCH, D_MODEL))
    ya = diff_attention(qa, ka, va, lam, subln_g, rel_bias_table[:, :A_HEADS], lambda_init)
    yb = window_attention(qb, kb, vb, sink, rel_bias_table[:, A_HEADS:])
    yc = axial_attention(qc, kc, vc, qk_g[0], qk_g[1], cos, sin)
    ys = jnp.stack([ya, yb, yc], axis=2)
    branches = jnp.einsum('bsnc,ncd->bsnd', ys, w_branch)
    merged = jnp.sum(gates * branches, axis=2)
    return merged @ w_out


def memory_attention(x, mem, w_q, w_kv, w_o):
    B, S, _ = x.shape
    M = mem.shape[1]
    scale = HEAD_DIM ** -0.5
    q = (x @ w_q).reshape(B, S, MEM_HEADS, HEAD_DIM)
    kv = (mem @ w_kv).reshape(B, M, 2, MEM_HEADS, HEAD_DIM)
    s = jnp.einsum('bqhd,bmhd->bhqm', q, kv[:, :, 0]).astype(jnp.float32) * scale
    p = jax.nn.softmax(s, axis=-1)
    o = jnp.einsum('bhqm,bmhd->bqhd', p.astype(x.dtype), kv[:, :, 1]).reshape(B, S, MEM_INNER)
    return o @ w_o


def run_trunk(x, mem, rel_bias_table, w_in, w_branch, w_out, lambda_qk, subln_g, sink_logits, qk_norm_g,
              w_mem_q, w_mem_kv, w_mem_o, w_ffn_gu, w_ffn_d, ln_g, ln_b):
    cos, sin = axial_rope_tables(x.shape[1])
    for i in range(DEPTH):
        lambda_init = 0.8 - 0.6 * math.exp(-0.3 * i)
        x = layer_norm(ALPHA * x + 0.5 * swiglu(x, w_ffn_gu[i, 0], w_ffn_d[i, 0]), ln_g[i, 0], ln_b[i, 0])
        x = layer_norm(ALPHA * x + parallel_mixer(x, w_in[i], w_branch[i], w_out[i], lambda_qk[i], subln_g[i],
                                                  sink_logits[i], qk_norm_g[i], rel_bias_table, lambda_init, cos, sin),
                       ln_g[i, 1], ln_b[i, 1])
        x = layer_norm(ALPHA * x + memory_attention(x, mem, w_mem_q[i], w_mem_kv[i], w_mem_o[i]), ln_g[i, 2], ln_b[i, 2])
        x = layer_norm(ALPHA * x + 0.5 * swiglu(x, w_ffn_gu[i, 1], w_ffn_d[i, 1]), ln_g[i, 3], ln_b[i, 3])
    return x


def setup_inputs(seed: int = 0) -> dict:
    key = jax.random.key(seed)
    ks = jax.random.split(key, 19)
    f32 = jnp.float32
    n = lambda k, shape: jax.random.normal(k, shape, dtype=f32)
    return {
        'x_prompt': n(ks[0], (BATCH, SEQ, D_MODEL)),
        'x_sample': n(ks[1], (DEC_BATCH, DEC_SEQ, D_MODEL)),
        'mem_prompt': n(ks[2], (BATCH, MEM_TOKENS, D_MODEL)),
        'mem_sample': n(ks[3], (DEC_BATCH, MEM_TOKENS, D_MODEL)),
        'rel_bias_table': 0.5 * n(ks[4], (NUM_BUCKETS, BIAS_HEADS)),
        'w_in': n(ks[5], (DEPTH, D_MODEL, IN_WIDTH)) * D_MODEL ** -0.5,
        'w_branch': n(ks[6], (DEPTH, N_BRANCH, BRANCH_WIDTH, D_MODEL)) * BRANCH_WIDTH ** -0.5,
        'w_out': n(ks[7], (DEPTH, D_MODEL, D_MODEL)) * (D_MODEL ** -0.5 * BETA),
        'lambda_qk': 0.1 * n(ks[8], (DEPTH, 4, HEAD_DIM)),
        'subln_g': 1.0 + 0.05 * n(ks[9], (DEPTH, A_V)),
        'sink_logits': n(ks[10], (DEPTH, B_HEADS)),
        'qk_norm_g': 1.0 + 0.05 * n(ks[11], (DEPTH, 2, HEAD_DIM)),
        'w_mem_q': n(ks[12], (DEPTH, D_MODEL, MEM_INNER)) * D_MODEL ** -0.5,
        'w_mem_kv': n(ks[13], (DEPTH, D_MODEL, 2 * MEM_INNER)) * D_MODEL ** -0.5,
        'w_mem_o': n(ks[14], (DEPTH, MEM_INNER, D_MODEL)) * (MEM_INNER ** -0.5 * BETA),
        'w_ffn_gu': n(ks[15], (DEPTH, 2, D_MODEL, 2 * D_FF)) * D_MODEL ** -0.5,
        'w_ffn_d': n(ks[16], (DEPTH, 2, D_FF, D_MODEL)) * (D_FF ** -0.5 * BETA),
        'ln_g': 1.0 + 0.05 * n(ks[17], (DEPTH, 4, D_MODEL)),
        'ln_b': 0.02 * n(ks[18], (DEPTH, 4, D_MODEL)),
    }


def reference(x_prompt, x_sample, mem_prompt, mem_sample, rel_bias_table, w_in, w_branch, w_out, lambda_qk,
              subln_g, sink_logits, qk_norm_g, w_mem_q, w_mem_kv, w_mem_o, w_ffn_gu, w_ffn_d, ln_g, ln_b):
    y_prompt = run_trunk(x_prompt, mem_prompt, rel_bias_table, w_in, w_branch, w_out, lambda_qk, subln_g,
                         sink_logits, qk_norm_g, w_mem_q, w_mem_kv, w_mem_o, w_ffn_gu, w_ffn_d, ln_g, ln_b)
    y_sample = run_trunk(x_sample, mem_sample, rel_bias_table, w_in, w_branch, w_out, lambda_qk, subln_g,
                         sink_logits, qk_norm_g, w_mem_q, w_mem_kv, w_mem_o, w_ffn_gu, w_ffn_d, ln_g, ln_b)
    return (y_prompt, y_sample)
```

```cpp
#include <hip/hip_runtime.h>
#include <cstdio>
#include <cstdint>

#ifndef MK_ONE_LAUNCH
#define MK_ONE_LAUNCH 0
#endif

namespace pg8 {
#define PG8_LAS __attribute__((address_space(3)))
typedef unsigned short bf16_t;
typedef short bf16x8 __attribute__((ext_vector_type(8)));
typedef float f32x4 __attribute__((ext_vector_type(4)));
typedef unsigned u32x4 __attribute__((ext_vector_type(4)));
constexpr int BM = 256, BK = 64, HALF = 128, HTB = HALF * BK * 2  , STAGE_BYTES = 8 * HTB, NXCD = 8, WGM = 8;

__host__ __device__ __forceinline__ int lds_byte(int r, int c) { const int st = (r >> 4) * 2 + (c >> 5), rr = r & 15, cc = c & 31, ob = rr * 64 + cc * 2; return st * 1024 + (ob ^ (((ob >> 9) & 1) << 5)); }
__host__ __device__ __forceinline__ void stage_rc(int b, int& R, int& C) { const int st = b / 1024, sb = b % 1024, swz = sb ^ (((sb >> 9) & 1) << 5); R = (st >> 1) * 16 + swz / 64; C = (st & 1) * 32 + (swz % 64) / 2; }
__host__ __device__ __forceinline__ int perm32(int rho) { const int n = rho >> 4, i = rho & 15; return 8 * (i >> 2) + 4 * n + (i & 3); }

struct Unit { int pm, pn; };
struct Gemm { const bf16_t* A; const bf16_t* Bt; int M, N, K; };

struct StaticOrder {
    int nM, nN, nwg, G, c;
    __host__ __device__ void init(int M, int N, int G_, int c_) { nM = M / BM; nN = N / BM; nwg = nM * nN; G = G_; c = c_; }
    __host__ __device__ bool next(int i, Unit& u) const {
        const long L = (long)i * G + c; if (L >= nwg) return false;
        int wgid = (int)L; { const int q = nwg / NXCD, r = nwg % NXCD, xcd = wgid % NXCD, off = wgid / NXCD; wgid = (xcd < r ? xcd * (q + 1) : r * (q + 1) + (xcd - r) * q) + off; }
        const int nig = WGM * nN, gid = wgid / nig, fm = gid * WGM, gsz = (nM - fm) < WGM ? (nM - fm) : WGM;
        u.pm = fm + ((wgid % nig) % gsz); u.pn = (wgid % nig) / gsz; return true;
    }
    __device__ __forceinline__ void a_ready(const Unit&) const {}
    __device__ __forceinline__ void done(const Unit&) const {}
};

__device__ __forceinline__ unsigned cvt_pk_bf16(float lo, float hi) { unsigned r; asm volatile("v_cvt_pk_bf16_f32 %0, %1, %2" : "=v"(r) : "v"(lo), "v"(hi)); return r; }
__device__ __forceinline__ float bf_lo(unsigned w) { return __uint_as_float(w << 16); }
__device__ __forceinline__ float bf_hi(unsigned w) { return __uint_as_float(w & 0xffff0000u); }
__device__ __forceinline__ float sigmoidf_fast(float v) { return __builtin_amdgcn_rcpf(1.0f + __builtin_amdgcn_exp2f(-1.4426950408889634f * v)); }

struct EpiSwiGLU {
    static constexpr bool PERM = true, AFTER_DRAIN = false;
    bf16_t* H; int ldh;
    __device__ __forceinline__ bool zero_after(const Unit&) const { return true; }
    __device__ __forceinline__ void operator()(f32x4 (&acc)[2][2][4][2], const Unit& u, int wr, int wc, int fr, int fq) const {
        const int row0 = u.pm * BM + wr * 64 + fr, col0 = u.pn * HALF + wc * 32 + 8 * fq;
#pragma unroll
        for (int ai = 0; ai < 2; ++ai)
#pragma unroll
            for (int m = 0; m < 4; ++m) { bf16_t* rowp = H + (size_t)(row0 + ai * HALF + m * 16) * ldh + col0;
                float hv[8];
#pragma unroll
                for (int n = 0; n < 2; ++n)
#pragma unroll
                    for (int j = 0; j < 4; ++j) { const float g = acc[ai][0][m][n][j], uu = acc[ai][1][m][n][j]; hv[n * 4 + j] = g * sigmoidf_fast(g) * uu; }
                u32x4 w; w.x = cvt_pk_bf16(hv[0], hv[1]); w.y = cvt_pk_bf16(hv[2], hv[3]); w.z = cvt_pk_bf16(hv[4], hv[5]); w.w = cvt_pk_bf16(hv[6], hv[7]);
                *(u32x4*)rowp = w; }
    }
};
struct EpiResid {
    static constexpr bool PERM = false, AFTER_DRAIN = false;
    const float* X; float* Z; int ldc; float alpha, s;
    __device__ __forceinline__ bool zero_after(const Unit&) const { return true; }
    __device__ __forceinline__ void operator()(f32x4 (&acc)[2][2][4][2], const Unit& u, int wr, int wc, int fr, int fq) const {
        const int row0 = u.pm * BM + wr * 64 + fr, col0 = u.pn * BM + wc * 32 + 4 * fq;
#pragma unroll
        for (int ai = 0; ai < 2; ++ai)
#pragma unroll
            for (int m = 0; m < 4; ++m) { const size_t off = (size_t)(row0 + ai * HALF + m * 16) * ldc + col0;
#pragma unroll
                for (int bj = 0; bj < 2; ++bj)
#pragma unroll
                    for (int n = 0; n < 2; ++n) { const f32x4 xv = *(const __attribute__((address_space(1))) f32x4*)(X + off + bj * HALF + n * 16);
                        *(__attribute__((address_space(1))) f32x4*)(Z + off + bj * HALF + n * 16) = xv * alpha + acc[ai][bj][m][n] * s; } }
    }
};
struct EpiBf16 {
    static constexpr bool PERM = true, AFTER_DRAIN = false;
    bf16_t* O; int ldc; int sig_from;
    __device__ __forceinline__ bool zero_after(const Unit&) const { return true; }
    __device__ __forceinline__ void operator()(f32x4 (&acc)[2][2][4][2], const Unit& u, int wr, int wc, int fr, int fq) const {
        const int row0 = u.pm * BM + wr * 64 + fr, col0 = u.pn * BM + wc * 32 + 8 * fq;
        const bool sg = u.pn >= sig_from;
#pragma unroll
        for (int ai = 0; ai < 2; ++ai)
#pragma unroll
            for (int m = 0; m < 4; ++m) { bf16_t* rowp = O + (size_t)(row0 + ai * HALF + m * 16) * ldc + col0;
#pragma unroll
                for (int bj = 0; bj < 2; ++bj) { f32x4 v0 = acc[ai][bj][m][0], v1 = acc[ai][bj][m][1];
                    if (sg) {
#pragma unroll
                        for (int j = 0; j < 4; ++j) { v0[j] = sigmoidf_fast(v0[j]); v1[j] = sigmoidf_fast(v1[j]); } }
                    u32x4 w; w.x = cvt_pk_bf16(v0[0], v0[1]); w.y = cvt_pk_bf16(v0[2], v0[3]); w.z = cvt_pk_bf16(v1[0], v1[1]); w.w = cvt_pk_bf16(v1[2], v1[3]);
                    *(u32x4*)(rowp + bj * HALF) = w; } }
    }
};
struct EpiBranch {
    static constexpr bool PERM = true, AFTER_DRAIN = false;
    const bf16_t* G; int ldg;
    bf16_t* O; int ldc;
    __device__ __forceinline__ bool zero_after(const Unit& u) const { return (u.pm >> 6) == 2; }
    __device__ __forceinline__ void operator()(f32x4 (&acc)[2][2][4][2], const Unit& u, int wr, int wc, int fr, int fq) const {
        const int nb = u.pm >> 6, pm = u.pm & 63, pn = u.pn & 7;
        const int row0 = pm * BM + wr * 64 + fr, col0 = pn * BM + wc * 32 + 8 * fq;
#pragma unroll
        for (int ai = 0; ai < 2; ++ai)
#pragma unroll
            for (int m = 0; m < 4; ++m) { const size_t r = (size_t)(row0 + ai * HALF + m * 16);
#pragma unroll
                for (int bj = 0; bj < 2; ++bj) {
                    const u32x4 ga = *(const u32x4*)(G + r * ldg + nb * 2048 + col0 + bj * HALF);
                    float f[8] = {bf_lo(ga.x), bf_hi(ga.x), bf_lo(ga.y), bf_hi(ga.y), bf_lo(ga.z), bf_hi(ga.z), bf_lo(ga.w), bf_hi(ga.w)};
                    if (nb < 2) { const u32x4 gb = *(const u32x4*)(G + r * ldg + (nb + 1) * 2048 + col0 + bj * HALF);
                        const float d[8] = {bf_lo(gb.x), bf_hi(gb.x), bf_lo(gb.y), bf_hi(gb.y), bf_lo(gb.z), bf_hi(gb.z), bf_lo(gb.w), bf_hi(gb.w)};
#pragma unroll
                        for (int j = 0; j < 8; ++j) f[j] = f[j] * __builtin_amdgcn_rcpf(fmaxf(d[j], 1e-30f));
                    }
#pragma unroll
                    for (int j = 0; j < 4; ++j) { acc[ai][bj][m][0][j] *= f[j]; acc[ai][bj][m][1][j] *= f[4 + j]; }
                    if (nb == 2) { const f32x4 v0 = acc[ai][bj][m][0], v1 = acc[ai][bj][m][1];
                        u32x4 w; w.x = cvt_pk_bf16(v0[0], v0[1]); w.y = cvt_pk_bf16(v0[2], v0[3]); w.z = cvt_pk_bf16(v1[0], v1[1]); w.w = cvt_pk_bf16(v1[2], v1[3]);
                        *(u32x4*)(O + r * ldc + col0 + bj * HALF) = w; } } }
    }
};
struct BranchOrder {
    StaticOrder so;
    __device__ void init(int G_, int c_) { so.init(16384, 2048, G_, c_); }
    __device__ bool next(int i, Unit& u) const { Unit t; if (!so.next(i / 3, t)) return false; const int n = i % 3; u.pm = n * 64 + t.pm; u.pn = n * 8 + t.pn; return true; }
    __device__ __forceinline__ void a_ready(const Unit&) const {}
    __device__ __forceinline__ void done(const Unit&) const {}
};

template <class Epi, class Sched, bool ALIGN_EPI = false, bool SP2 = false>
__device__ __forceinline__ void gemm_phase(PG8_LAS unsigned char* lds, const Gemm g, const Sched& S, const Epi& E) {
    int tid = threadIdx.x; asm volatile("" : "+v"(tid)); const int wid = __builtin_amdgcn_readfirstlane(tid >> 6), lane = tid & 63, wr = wid >> 2, wc = wid & 3, fr = lane & 15, fq = lane >> 4;
    const int K = g.K, nt = K / BK;
    unsigned voffA[2], voffB[2];
#pragma unroll
    for (int i = 0; i < 2; ++i) { int R, C; stage_rc(tid * 16 + i * 8192, R, C); const int Rb = Epi::PERM ? ((R & ~31) + perm32(R & 31)) : R;
        voffA[i] = (unsigned)(R * K + C) * 2u; voffB[i] = (unsigned)(Rb * K + C) * 2u; }
    const size_t kstep = (size_t)(BK * 2);
    const size_t hstep = (size_t)HALF * K * 2;
    const size_t tstep = 2 * hstep;
    const unsigned ldsw = (unsigned)wid * 1024u;
    const int aoff = lds_byte(wr * 64 + fr, fq * 8), boff = lds_byte(wc * 32 + fr, fq * 8);
#define PG8_SA(b, h) (((b) * 2 + (h)) * HTB)
#define PG8_SB(b, h) ((4 + (b) * 2 + (h)) * HTB)
#define PG8_STAGE(bufoff, gbase, voff) do { _Pragma("unroll") for (int _i = 0; _i < 2; ++_i) \
        __builtin_amdgcn_global_load_lds((const unsigned*)((const char*)(gbase) + (voff)[_i]), (PG8_LAS unsigned*)(lds + (bufoff) + ldsw + _i * 8192), 16, 0, 0); } while (0)
#define PG8_LDA(dst, b, h) do { _Pragma("unroll") for (int m = 0; m < 4; ++m) _Pragma("unroll") for (int k = 0; k < 2; ++k) dst[m][k] = *(const PG8_LAS bf16x8*)(lds + PG8_SA(b, h) + aoff + m * 2048 + k * 1024); } while (0)
#define PG8_LDB(dst, b, h) do { _Pragma("unroll") for (int n = 0; n < 2; ++n) _Pragma("unroll") for (int k = 0; k < 2; ++k) dst[n][k] = *(const PG8_LAS bf16x8*)(lds + PG8_SB(b, h) + boff + n * 2048 + k * 1024); } while (0)
#define PG8_MMA(ai, bj, At, Bt) do { __builtin_amdgcn_s_setprio(1); _Pragma("unroll") for (int m = 0; m < 4; ++m) _Pragma("unroll") for (int n = 0; n < 2; ++n) _Pragma("unroll") for (int k = 0; k < 2; ++k) \
        acc[ai][bj][m][n] = __builtin_amdgcn_mfma_f32_16x16x32_bf16(Bt[n][k], At[m][k], acc[ai][bj][m][n], 0, 0, 0); __builtin_amdgcn_s_setprio(0); } while (0)
#define PG8_WAIT_V(n) asm volatile("s_waitcnt vmcnt(" #n ")" ::: "memory")
#define PG8_WAIT_L(n) asm volatile("s_waitcnt lgkmcnt(" #n ")" ::: "memory")
#define PG8_BAR __builtin_amdgcn_s_barrier()
#define PG8_SCHED __builtin_amdgcn_sched_barrier(0)
    Unit cur, nxt; int ui = 0;
    if (!S.next(0, cur)) return;
    f32x4 acc[2][2][4][2];
#pragma unroll
    for (int a = 0; a < 2; ++a)
#pragma unroll
        for (int b = 0; b < 2; ++b)
#pragma unroll
            for (int m = 0; m < 4; ++m)
#pragma unroll
                for (int n = 0; n < 2; ++n) acc[a][b][m][n] = (f32x4){0.f, 0.f, 0.f, 0.f};
    bf16x8 At[4][2], B0[2][2], B1[2][2];
    const char* cA = (const char*)g.A + (size_t)cur.pm * tstep; const char* cB = (const char*)g.Bt + (size_t)cur.pn * tstep;
    S.a_ready(cur);
    if constexpr (SP2) {
        PG8_STAGE(PG8_SB(0, 0), cB, voffB); PG8_STAGE(PG8_SB(0, 1), cB + hstep, voffB); PG8_STAGE(PG8_SA(0, 0), cA, voffA); PG8_STAGE(PG8_SA(0, 1), cA + hstep, voffA);
        if (wr == 1) PG8_BAR;
        PG8_WAIT_V(2); PG8_BAR;
        PG8_STAGE(PG8_SB(1, 0), cB + kstep, voffB); PG8_STAGE(PG8_SA(1, 0), cA + kstep, voffA); PG8_STAGE(PG8_SB(1, 1), cB + hstep + kstep, voffB);
        PG8_WAIT_V(6); PG8_BAR;
    } else {
        PG8_STAGE(PG8_SB(0, 0), cB, voffB); PG8_STAGE(PG8_SA(0, 0), cA, voffA); PG8_STAGE(PG8_SB(0, 1), cB + hstep, voffB); PG8_STAGE(PG8_SA(0, 1), cA + hstep, voffA);
        if (wr == 1) PG8_BAR;
        PG8_WAIT_V(4); PG8_BAR;
        PG8_STAGE(PG8_SB(1, 0), cB + kstep, voffB); PG8_STAGE(PG8_SA(1, 0), cA + kstep, voffA); PG8_STAGE(PG8_SB(1, 1), cB + hstep + kstep, voffB);
        PG8_WAIT_V(6); PG8_BAR;
    }
    for (;;) {
        const bool has_next = S.next(ui + 1, nxt);
        const char* nA = has_next ? (const char*)g.A + (size_t)nxt.pm * tstep : cA; const char* nB = has_next ? (const char*)g.Bt + (size_t)nxt.pn * tstep : cB;
        for (int t = 0; t < nt; t += 2) {
            const bool last = (t == nt - 2);
            const char* a1 = cA + (size_t)(t + 1) * kstep;
            const char* a2 = last ? nA : cA + (size_t)(t + 2) * kstep; const char* b2 = last ? nB : cB + (size_t)(t + 2) * kstep;
            const char* a3 = a2 + kstep; const char* b3 = b2 + kstep;
            if (last && has_next) S.a_ready(nxt);
            if constexpr (SP2) {
            PG8_LDB(B0, 0, 0); PG8_LDB(B1, 0, 1); PG8_SCHED; PG8_LDA(At, 0, 0); PG8_STAGE(PG8_SA(1, 1), a1 + hstep, voffA);
            PG8_WAIT_V(8); PG8_WAIT_L(0); PG8_BAR; PG8_MMA(0, 0, At, B0); PG8_MMA(0, 1, At, B1); PG8_BAR; PG8_SCHED;
            PG8_LDA(At, 0, 1); PG8_STAGE(PG8_SB(0, 0), b2, voffB); PG8_STAGE(PG8_SB(0, 1), b2 + hstep, voffB); PG8_STAGE(PG8_SA(0, 0), a2, voffA);
            PG8_WAIT_V(8); PG8_WAIT_L(0); PG8_BAR; PG8_MMA(1, 0, At, B0); PG8_MMA(1, 1, At, B1); PG8_BAR; PG8_SCHED;
            PG8_LDB(B0, 1, 0); PG8_LDB(B1, 1, 1); PG8_SCHED; PG8_LDA(At, 1, 0); PG8_STAGE(PG8_SA(0, 1), a2 + hstep, voffA);
            PG8_WAIT_V(8); PG8_WAIT_L(0); PG8_BAR; PG8_MMA(0, 0, At, B0); PG8_MMA(0, 1, At, B1); PG8_BAR; PG8_SCHED;
            PG8_LDA(At, 1, 1); PG8_STAGE(PG8_SB(1, 0), b3, voffB); PG8_STAGE(PG8_SB(1, 1), b3 + hstep, voffB); PG8_STAGE(PG8_SA(1, 0), a3, voffA);
            PG8_WAIT_V(8); PG8_WAIT_L(0); PG8_BAR; PG8_MMA(1, 0, At, B0); PG8_MMA(1, 1, At, B1); PG8_BAR; PG8_SCHED;
            } else {
            PG8_LDB(B0, 0, 0); PG8_SCHED; PG8_LDA(At, 0, 0); PG8_STAGE(PG8_SA(1, 1), a1 + hstep, voffA);
            PG8_WAIT_L(8); PG8_BAR; PG8_WAIT_L(0); PG8_MMA(0, 0, At, B0); PG8_BAR; PG8_SCHED;
            PG8_LDB(B1, 0, 1); PG8_STAGE(PG8_SB(0, 0), b2, voffB);
            PG8_BAR; PG8_WAIT_L(0); PG8_MMA(0, 1, At, B1); PG8_BAR;
            PG8_LDA(At, 0, 1); PG8_STAGE(PG8_SA(0, 0), a2, voffA);
            PG8_BAR; PG8_WAIT_L(0); PG8_MMA(1, 0, At, B0); PG8_BAR; PG8_SCHED;
            PG8_STAGE(PG8_SB(0, 1), b2 + hstep, voffB);
            PG8_WAIT_V(6); PG8_BAR; PG8_MMA(1, 1, At, B1); PG8_BAR;
            PG8_LDB(B0, 1, 0); PG8_SCHED; PG8_LDA(At, 1, 0); PG8_STAGE(PG8_SA(0, 1), a2 + hstep, voffA);
            PG8_WAIT_L(8); PG8_BAR; PG8_WAIT_L(0); PG8_MMA(0, 0, At, B0); PG8_BAR; PG8_SCHED;
            PG8_LDB(B1, 1, 1); PG8_STAGE(PG8_SB(1, 0), b3, voffB);
            PG8_BAR; PG8_WAIT_L(0); PG8_MMA(0, 1, At, B1); PG8_BAR;
            PG8_LDA(At, 1, 1); PG8_STAGE(PG8_SA(1, 0), a3, voffA);
            PG8_BAR; PG8_WAIT_L(0); PG8_MMA(1, 0, At, B0); PG8_BAR; PG8_SCHED;
            PG8_STAGE(PG8_SB(1, 1), b3 + hstep, voffB);
            PG8_WAIT_V(6); PG8_BAR; PG8_MMA(1, 1, At, B1); PG8_BAR;
            }
        }
        if constexpr (ALIGN_EPI) { if (wr == 0) PG8_BAR; }
        if constexpr (!Epi::AFTER_DRAIN) { E(acc, cur, wr, wc, fr, fq); S.done(cur); }
        if (!has_next) break;
        if (E.zero_after(cur)) {
#pragma unroll
        for (int a = 0; a < 2; ++a)
#pragma unroll
            for (int b = 0; b < 2; ++b)
#pragma unroll
                for (int m = 0; m < 4; ++m)
#pragma unroll
                    for (int n = 0; n < 2; ++n) acc[a][b][m][n] = (f32x4){0.f, 0.f, 0.f, 0.f};
        }
        cur = nxt; cA = nA; cB = nB; ++ui;
        if constexpr (ALIGN_EPI) { if (wr == 1) PG8_BAR; }
    }
    PG8_WAIT_V(0);
    if constexpr (!ALIGN_EPI) { if (wr == 0) PG8_BAR; }
    PG8_BAR;
    if constexpr (Epi::AFTER_DRAIN) { E.fused(acc, cur, wr, wc, fr, fq, lds, wid, lane); S.done(cur); }
#undef PG8_SA
#undef PG8_SB
#undef PG8_STAGE
#undef PG8_LDA
#undef PG8_LDB
#undef PG8_MMA
#undef PG8_WAIT_V
#undef PG8_WAIT_L
#undef PG8_BAR
#undef PG8_SCHED
}
}

namespace att {
typedef unsigned short bf16;
constexpr int D = 128, NW = 8, QBLK = 32, KVBLK = 64;
constexpr float SCALE = 0.088388347648318440f;
constexpr float THR = 8.f;
constexpr int SHM_V = KVBLK * D * 2, SHM_K = KVBLK * D * 2;
constexpr int OFF_WS = 2 * SHM_V + 2 * SHM_K, OFF_TBL = OFF_WS + NW * 64 * 4, OFF_Q = OFF_TBL + 1280, LDS_BYTES = OFF_Q + 64;
constexpr int TBL_N = 259, TBL_PITCH = 260;
using bf16x8 = __attribute__((ext_vector_type(8))) short;
using s16x4  = __attribute__((ext_vector_type(4))) short;
using f32x16 = __attribute__((ext_vector_type(16))) float;
using u32x4  = __attribute__((ext_vector_type(4))) unsigned;
#define KSWZ(row, colB) ((row) * 256 + ((colB) ^ (((row) & 7) << 4)))
#define SBAR() __builtin_amdgcn_sched_barrier(0)
__device__ __forceinline__ int crow(int r, int hi) { return (r & 3) + 8 * (r >> 2) + 4 * hi; }
__device__ __forceinline__ unsigned cvtpk(float lo, float hi) { unsigned r; asm volatile("v_cvt_pk_bf16_f32 %0, %1, %2" : "=v"(r) : "v"(lo), "v"(hi)); return r; }

__device__ __forceinline__ void partialSM(f32x16& p0, f32x16& p1, float& m_reg, float& mn, float& alpha) {
  constexpr float C = SCALE * 1.4426950408889634f;
  float pmax = p0[0];
#pragma unroll
  for (int r = 1; r < 16; ++r) pmax = fmaxf(pmax, p0[r]);
#pragma unroll
  for (int r = 0; r < 16; ++r) pmax = fmaxf(pmax, p1[r]);
  { auto rr = __builtin_amdgcn_permlane32_swap(__float_as_uint(pmax), __float_as_uint(pmax), false, false);
    pmax = fmaxf(__uint_as_float(rr[0]), __uint_as_float(rr[1])); }
  if (__builtin_expect(__all(pmax - m_reg <= THR / SCALE), 1)) { mn = m_reg; alpha = 1.f; }
  else { mn = fmaxf(m_reg, pmax); alpha = __builtin_amdgcn_exp2f((m_reg - mn) * C); m_reg = mn; }
  float mnC = -mn * C;
#pragma unroll
  for (int r = 0; r < 16; ++r) p0[r] = fmaf(p0[r], C, mnC);
#pragma unroll
  for (int r = 0; r < 16; ++r) p1[r] = fmaf(p1[r], C, mnC);
#pragma unroll
  for (int r = 0; r < 16; ++r) p0[r] = __builtin_amdgcn_exp2f(p0[r]);
}
__device__ __forceinline__ void finishSM(f32x16& p0, f32x16& p1, float alpha, float& l_reg, bf16x8& pa0, bf16x8& pa1, bf16x8& pa2, bf16x8& pa3) {
#pragma unroll
  for (int r = 0; r < 16; ++r) p1[r] = __builtin_amdgcn_exp2f(p1[r]);
  float ps = 0;
#pragma unroll
  for (int r = 0; r < 16; ++r) ps += p0[r];
#pragma unroll
  for (int r = 0; r < 16; ++r) ps += p1[r];
  { auto rr = __builtin_amdgcn_permlane32_swap(__float_as_uint(ps), __float_as_uint(ps), false, false);
    ps = __uint_as_float(rr[0]) + __uint_as_float(rr[1]); }
  l_reg = l_reg * alpha + ps;
#define PK4(P, BASE, OUT) do { unsigned a0 = cvtpk(P[BASE + 0], P[BASE + 1]), a1 = cvtpk(P[BASE + 2], P[BASE + 3]);   \
    unsigned b0 = cvtpk(P[BASE + 4], P[BASE + 5]), b1 = cvtpk(P[BASE + 6], P[BASE + 7]);                              \
    auto r0 = __builtin_amdgcn_permlane32_swap(a0, b0, false, false); auto r1 = __builtin_amdgcn_permlane32_swap(a1, b1, false, false); \
    u32x4 w = {r0[0], r1[0], r0[1], r1[1]}; OUT = *reinterpret_cast<bf16x8*>(&w); } while (0)
  PK4(p0, 0, pa0); PK4(p0, 8, pa1); PK4(p1, 0, pa2); PK4(p1, 8, pa3);
#undef PK4
}
__device__ __forceinline__ void qkt(f32x16& p0, f32x16& p1, const bf16* Ks, const bf16x8* qr, int r32, int hi, float cinit) {
#pragma unroll
  for (int r = 0; r < 16; ++r) { p0[r] = cinit; p1[r] = cinit; }
#pragma unroll
  for (int d0 = 0; d0 < 8; ++d0) { int cb = (d0 * 16 + hi * 8) * 2;
    bf16x8 b0 = *reinterpret_cast<const bf16x8*>((const char*)Ks + KSWZ(r32, cb));
    bf16x8 b1 = *reinterpret_cast<const bf16x8*>((const char*)Ks + KSWZ(32 + r32, cb));
    p0 = __builtin_amdgcn_mfma_f32_32x32x16_bf16(b0, qr[d0], p0, 0, 0, 0);
    p1 = __builtin_amdgcn_mfma_f32_32x32x16_bf16(b1, qr[d0], p1, 0, 0, 0); }
}
__device__ __forceinline__ void add_bias(f32x16& p0, f32x16& p1, const float* tbl, int base) {
#pragma unroll
  for (int r = 0; r < 16; ++r) { const int c = (r & 3) + 8 * (r >> 2);
    int i0 = base + c, i1 = base + 32 + c; i0 = min(max(i0, 0), TBL_N - 1); i1 = min(max(i1, 0), TBL_N - 1);
    p0[r] += tbl[i0]; p1[r] += tbl[i1]; }
}
__device__ __forceinline__ int v_st(int k, int c) { const int kk = (k & ~0xC) | ((k & 4) << 1) | ((k & 8) >> 1); return ((kk >> 3) * 4 + (c >> 5)) * 512 + ((kk & 7) * 32 + (c & 31)) * 2; }
__device__ __forceinline__ int v_rd_base(int lane) { return ((lane & 3) << 3) | (((lane >> 2) & 3) << 6) | (((lane >> 4) & 1) << 5) | (((lane >> 5) & 1) << 8); }
constexpr int v_rd_off(int d0, int ks, int half) { return d0 * 512 + ks * 4096 + half * 2048; }
template <int OFF> __device__ __forceinline__ s16x4 tr_read(int vb) {
  s16x4 r; asm volatile("ds_read_b64_tr_b16 %0, %1 offset:%2" : "=&v"(r) : "v"(vb), "i"(OFF) : "memory"); return r;
}
template <int D0> __device__ __forceinline__ void pv_one(f32x16& od, int vb, bf16x8 pa0, bf16x8 pa1, bf16x8 pa2, bf16x8 pa3) {
  const s16x4 l0 = tr_read<v_rd_off(D0, 0, 0)>(vb), h0 = tr_read<v_rd_off(D0, 0, 1)>(vb), l1 = tr_read<v_rd_off(D0, 1, 0)>(vb), h1 = tr_read<v_rd_off(D0, 1, 1)>(vb);
  const s16x4 l2 = tr_read<v_rd_off(D0, 2, 0)>(vb), h2 = tr_read<v_rd_off(D0, 2, 1)>(vb), l3 = tr_read<v_rd_off(D0, 3, 0)>(vb), h3 = tr_read<v_rd_off(D0, 3, 1)>(vb);
  asm volatile("s_waitcnt lgkmcnt(0)" ::: "memory"); SBAR();
#define PK(L, H) (bf16x8){L[0], L[1], L[2], L[3], H[0], H[1], H[2], H[3]}
  od = __builtin_amdgcn_mfma_f32_32x32x16_bf16(pa0, PK(l0, h0), od, 0, 0, 0);
  od = __builtin_amdgcn_mfma_f32_32x32x16_bf16(pa1, PK(l1, h1), od, 0, 0, 0);
  od = __builtin_amdgcn_mfma_f32_32x32x16_bf16(pa2, PK(l2, h2), od, 0, 0, 0);
  od = __builtin_amdgcn_mfma_f32_32x32x16_bf16(pa3, PK(l3, h3), od, 0, 0, 0);
#undef PK
}
__device__ __forceinline__ void pv_d0(f32x16* o, int vb, bf16x8 pa0, bf16x8 pa1, bf16x8 pa2, bf16x8 pa3) {
  pv_one<0>(o[0], vb, pa0, pa1, pa2, pa3); pv_one<1>(o[1], vb, pa0, pa1, pa2, pa3); pv_one<2>(o[2], vb, pa0, pa1, pa2, pa3); pv_one<3>(o[3], vb, pa0, pa1, pa2, pa3);
}

struct UnitP {
  const bf16* Q; const bf16* K; const bf16* V;
  void* O;
  int nt;
  int rel0;
  int mode;
  const float* tbl;
  float sink_l2;
  int obf;
};

template <int LDQ, int LDK, int LDO, bool BIAS>
__device__ __forceinline__ void attn_unit(const UnitP& P, char* lds) {
  int tid = threadIdx.x; asm volatile("" : "+v"(tid)); const int wid = __builtin_amdgcn_readfirstlane(tid >> 6), lane = tid & 63, r32 = lane & 31, hi = lane >> 5;
  bf16* V_lds = (bf16*)lds; bf16* K_lds = (bf16*)(lds + 2 * SHM_V);
  float* ws = (float*)(lds + OFF_WS) + wid * 64; float* li_l = ws; float* al_l = ws + 32;
  float* tblL = (float*)(lds + OFF_TBL);
  const bf16* __restrict__ Kh = P.K; const bf16* __restrict__ Vh = P.V;
  float m_reg = -1e30f, l_reg = 0; f32x16 o[4] = {}; bf16x8 qr[8];
  const bf16* Qw = P.Q + (long)(wid * QBLK + r32) * LDQ + hi * 8;
#pragma unroll
  for (int d0 = 0; d0 < 8; ++d0) qr[d0] = *reinterpret_cast<const bf16x8*>(Qw + d0 * 16);
  float cL = 0.f, cR = 0.f;
  if (BIAS) { if (P.mode != 0) { if (tid < TBL_N) tblL[tid] = P.tbl[tid]; cL = P.tbl[0]; cR = P.tbl[TBL_N - 1]; } }
  const int relw = P.rel0 - wid * QBLK;
  const int lbase = relw - r32 + 129 + 4 * hi;
  const int sr = tid >> 4, sc = (tid & 15) * 8, vst0 = v_st(sr, sc), vst1 = v_st(32 + sr, sc);
  const int vb0 = (int)(uintptr_t)V_lds + v_rd_base(lane);
  struct { bf16x8 vs0, vs1, ks0, ks1; } sr_[2];
#define SLOAD(i, k0) do { sr_[i].vs0 = *reinterpret_cast<const bf16x8*>(&Vh[(long)((k0) + sr) * LDK + sc]); sr_[i].vs1 = *reinterpret_cast<const bf16x8*>(&Vh[(long)((k0) + 32 + sr) * LDK + sc]); \
    sr_[i].ks0 = *reinterpret_cast<const bf16x8*>(&Kh[(long)((k0) + sr) * LDK + sc]); sr_[i].ks1 = *reinterpret_cast<const bf16x8*>(&Kh[(long)((k0) + 32 + sr) * LDK + sc]); } while (0)
#define SWRITE(b, i) do { *(bf16x8*)((char*)V_lds + (b) * SHM_V + vst0) = sr_[i].vs0;          \
    *(bf16x8*)((char*)V_lds + (b) * SHM_V + vst1) = sr_[i].vs1; int kc = sc * 2;               \
    *(bf16x8*)((char*)K_lds + (b) * SHM_K + KSWZ(sr, kc)) = sr_[i].ks0;                       \
    *(bf16x8*)((char*)K_lds + (b) * SHM_K + KSWZ(32 + sr, kc)) = sr_[i].ks1; } while (0)
#define SWAIT() asm volatile("s_waitcnt vmcnt(4)" ::: "memory")
#define RESC(a) do { if (__any((a) < 1.f)) { if (hi == 0) al_l[r32] = (a); asm volatile("s_waitcnt lgkmcnt(0)" ::: "memory"); \
    _Pragma("unroll") for (int d = 0; d < 4; ++d) _Pragma("unroll") for (int r = 0; r < 16; ++r) o[d][r] *= al_l[crow(r, hi)]; } } while (0)
#define CINIT(j, cin, slow) do { cin = 0.f; slow = false; if (BIAS) { const int dmin = relw + 64 * (j) - 31, dmax = relw + 64 * (j) + 63; \
    if (P.mode == 1 && dmax <= -91) cin = cL; else if (P.mode == 1 && dmin >= 91) cin = cR; else slow = (P.mode != 0); } } while (0)
#define TBIAS(j, slow, p0, p1) do { if (BIAS) { if (slow) add_bias(p0, p1, tblL, lbase + 64 * (j)); } } while (0)
  f32x16 pA0, pA1, pB0, pB1; float mnA, mnB, alA, alB; bf16x8 pa0, pa1, pa2, pa3; const int NT = P.nt;
  float cinA, cinB; bool slA, slB;
  constexpr int SE = 0, SO = 1;
  SLOAD(SE, 0); asm volatile("s_waitcnt vmcnt(0)" ::: "memory"); SWRITE(0, SE); __syncthreads();
  CINIT(0, cinA, slA);
  qkt(pA0, pA1, K_lds, qr, r32, hi, cinA); TBIAS(0, slA, pA0, pA1); partialSM(pA0, pA1, m_reg, mnA, alA);
  SLOAD(SO, KVBLK); if (2 < NT) SLOAD(SE, 2 * KVBLK);
  SWAIT(); SWRITE(1, SO); __syncthreads();
  for (int j = 1; j + 1 < NT; j += 2) {
    CINIT(j, cinB, slB);
    SBAR(); qkt(pB0, pB1, (bf16*)((char*)K_lds + SHM_K), qr, r32, hi, cinB);
    finishSM(pA0, pA1, alA, l_reg, pa0, pa1, pa2, pa3); SBAR();
    SLOAD(SO, (j + 2) * KVBLK); SBAR();
    pv_d0(o, vb0, pa0, pa1, pa2, pa3); TBIAS(j, slB, pB0, pB1); partialSM(pB0, pB1, m_reg, mnB, alB);
    __syncthreads(); SWAIT(); SWRITE(0, SE);
    RESC(alB); __syncthreads();
    CINIT(j + 1, cinA, slA);
    SBAR(); qkt(pA0, pA1, K_lds, qr, r32, hi, cinA);
    finishSM(pB0, pB1, alB, l_reg, pa0, pa1, pa2, pa3); SBAR();
    if (j + 3 < NT) SLOAD(SE, (j + 3) * KVBLK); SBAR();
    pv_d0(o, vb0 + (int)SHM_V, pa0, pa1, pa2, pa3); TBIAS(j + 1, slA, pA0, pA1); partialSM(pA0, pA1, m_reg, mnA, alA);
    __syncthreads(); SWAIT(); SWRITE(1, SO);
    RESC(alA); __syncthreads();
  }
  CINIT(NT - 1, cinB, slB);
  SBAR(); qkt(pB0, pB1, (bf16*)((char*)K_lds + SHM_K), qr, r32, hi, cinB);
  finishSM(pA0, pA1, alA, l_reg, pa0, pa1, pa2, pa3); SBAR();
  pv_d0(o, vb0, pa0, pa1, pa2, pa3); TBIAS(NT - 1, slB, pB0, pB1); partialSM(pB0, pB1, m_reg, mnB, alB);
  __syncthreads(); RESC(alB);
  finishSM(pB0, pB1, alB, l_reg, pa0, pa1, pa2, pa3); SBAR();
  pv_d0(o, vb0 + (int)SHM_V, pa0, pa1, pa2, pa3);
  if (BIAS) l_reg += __builtin_amdgcn_exp2f(P.sink_l2 - m_reg * (SCALE * 1.4426950408889634f));
  if (hi == 0) li_l[r32] = l_reg; asm volatile("s_waitcnt lgkmcnt(0)" ::: "memory");
  float rli[16];
#pragma unroll
  for (int r = 0; r < 16; ++r) rli[r] = __builtin_amdgcn_rcpf(li_l[crow(r, hi)]);
  if (P.obf) { bf16* Ow = (bf16*)P.O + (long)(wid * QBLK) * LDO;
#pragma unroll
    for (int r = 0; r < 16; ++r) { const int orow = crow(r, hi);
#pragma unroll
      for (int d0 = 0; d0 < 4; ++d0) Ow[(long)orow * LDO + d0 * 32 + r32] = (bf16)(cvtpk(o[d0][r] * rli[r], 0.f) & 0xffffu); }
  } else { float* Ow = (float*)P.O + (long)(wid * QBLK) * LDO;
#pragma unroll
    for (int r = 0; r < 16; ++r) { const int orow = crow(r, hi);
#pragma unroll
      for (int d0 = 0; d0 < 4; ++d0) Ow[(long)orow * LDO + d0 * 32 + r32] = o[d0][r] * rli[r]; }
  }
  __syncthreads();
#undef SLOAD
#undef SWRITE
#undef SWAIT
#undef RESC
#undef CINIT
#undef TBIAS
}
#undef KSWZ
#undef SBAR
}


constexpr int NWAVES = 8;
constexpr int DM = 2048, DFF = 5632, DEPTH = 4, INW = 12288, MEMI = 512;
constexpr int M = 16384;
constexpr int MEMROWS = 1536;
constexpr float ALPHA = 1.6817928305074290f;
constexpr float LN_EPS = 1e-5f, RMS_EPS = 1e-6f;
constexpr int C_QA = 0, C_KA = 1024, C_VA = 2048, C_QB = 3072, C_KB = 4096, C_VB = 4352, C_QC = 4608, C_KC = 5632, C_VC = 5888, C_GATE = 6144;

constexpr size_t MiB = 1u << 20;
constexpr size_t WS_CTL = 0, CTL_ZERO_BYTES = 1 * MiB;
constexpr size_t WS_BT = 1 * MiB;
constexpr size_t WS_COS = 2 * MiB, WS_SIN = 3 * MiB;
constexpr size_t WS_WGU = 4 * MiB;
constexpr size_t SZ_WGU = (size_t)11264 * 2048 * 2;
constexpr size_t WS_WD = WS_WGU + 8 * SZ_WGU;
constexpr size_t SZ_WD = (size_t)2048 * 5632 * 2;
constexpr size_t WS_WIN = WS_WD + 8 * SZ_WD;
constexpr size_t SZ_WIN = (size_t)12288 * 2048 * 2;
constexpr size_t WS_WBR = WS_WIN + 4 * SZ_WIN;
constexpr size_t SZ_WBR = (size_t)3 * 2048 * 1024 * 2;
constexpr size_t WS_WOUT = WS_WBR + 4 * SZ_WBR;
constexpr size_t SZ_WOUT = (size_t)2048 * 2048 * 2;
constexpr size_t WS_WMQ = WS_WOUT + 4 * SZ_WOUT;
constexpr size_t SZ_WMQ = (size_t)512 * 2048 * 2;
constexpr size_t WS_WMKV = WS_WMQ + 4 * SZ_WMQ;
constexpr size_t SZ_WMKV = (size_t)1024 * 2048 * 2;
constexpr size_t WS_WMO = WS_WMKV + 4 * SZ_WMKV;
constexpr size_t SZ_WMO = (size_t)2048 * 512 * 2;
constexpr size_t WS_XB = WS_WMO + 4 * SZ_WMO;
constexpr size_t WS_Z = WS_XB + (size_t)M * DM * 2;
constexpr size_t WS_H = WS_Z + (size_t)M * DM * 4;
constexpr size_t WS_P = WS_H + (size_t)M * DFF * 2;
constexpr size_t WS_O12 = WS_P + (size_t)M * INW * 2;
constexpr size_t WS_YS = WS_O12 + (size_t)2 * M * 1024 * 4;
constexpr size_t WS_MG = WS_YS + (size_t)3 * M * 1024 * 2;
constexpr size_t WS_MQ = WS_MG + (size_t)M * DM * 2;
constexpr size_t WS_MO = WS_MQ + (size_t)M * MEMI * 2;
constexpr size_t WS_MKV = WS_MO + (size_t)M * MEMI * 2;
constexpr size_t WS_MEMB = WS_MKV + (size_t)MEMROWS * 4096 * 2;
constexpr size_t WS_END = WS_MEMB + (size_t)MEMROWS * DM * 2;
constexpr int CW_Q = 1024;
constexpr int CW_BAR = 4096;
constexpr int MAX_BAR_REGIONS = 70;
constexpr int RING_BYTES = 131072, LDSCTL_OFF = RING_BYTES, MISC_OFF = LDSCTL_OFF + 320, LDS_BYTES = 147456;

#define GAS __attribute__((address_space(1)))
#define LAS __attribute__((address_space(3)))
typedef unsigned short bf16;
typedef unsigned v4u __attribute__((ext_vector_type(4)));
typedef unsigned v2u __attribute__((ext_vector_type(2)));
typedef float f32x4 __attribute__((ext_vector_type(4)));
#define LDS_WAIT() asm volatile("s_waitcnt lgkmcnt(0)" ::: "memory")
#define VM_WAIT() asm volatile("s_waitcnt vmcnt(0)" ::: "memory")
__device__ __forceinline__ unsigned pk2(float lo, float hi) { unsigned r; asm volatile("v_cvt_pk_bf16_f32 %0, %1, %2" : "=v"(r) : "v"(lo), "v"(hi)); return r; }
__device__ __forceinline__ float bf2f(unsigned short h) { return __uint_as_float(((unsigned)h) << 16); }

#define XB_TMO      128
#define XB_XCNT(j)  (256  + 64 * (j))
#define XB_XSUB(j)  (1280 + 64 * (j))
#define XB_XGEN(j)  (2304 + 64 * (j))
#define XB_TOP      3328
#define XB_TOPGEN   3392
#define XCD_BAR_WORDS 3456
#define XB_SPIN_CAP (1u << 18)

__device__ __forceinline__ unsigned xb_ld(unsigned* p)              { return __hip_atomic_load(p, __ATOMIC_RELAXED, __HIP_MEMORY_SCOPE_AGENT); }
__device__ __forceinline__ unsigned xb_add(unsigned* p, unsigned v) { return __hip_atomic_fetch_add(p, v, __ATOMIC_RELAXED, __HIP_MEMORY_SCOPE_AGENT); }
__device__ __forceinline__ unsigned xb_xcc_id() { return (unsigned)__builtin_amdgcn_s_getreg((3 << 11) | 20) & 0xFu; }
#define XB_SPIN(cond, bar) do { unsigned _sp = 0; while (cond) { __builtin_amdgcn_s_sleep(1); \
    if ((++_sp & 255u) == 0u) { if (xb_ld(&(bar)[XB_TMO])) break; if (_sp > XB_SPIN_CAP) { atomicAdd(&(bar)[XB_TMO], 1u); break; } } } } while (0)

struct XcdBarrier {
    unsigned* bar; unsigned x;
    volatile LAS unsigned* st;
};

__device__ __forceinline__ XcdBarrier xcd_barrier_post(unsigned* bar, volatile LAS unsigned* st) {
    XcdBarrier b; b.bar = bar; b.x = xb_xcc_id(); b.st = st;
    if (threadIdx.x == 0) (void)xb_add(&bar[XB_XCNT(b.x)], 1u);
    return b;
}
__device__ __forceinline__ void xcd_barrier_complete(unsigned* bar, unsigned x, unsigned& nloc, unsigned& nx) {
    const unsigned G = gridDim.x * gridDim.y * gridDim.z;
    unsigned sum, cnt, mine, sp = 0u;
    for (;;) {
        sum = 0u; cnt = 0u; mine = 0u;
#pragma unroll
        for (unsigned j = 0; j < 16; ++j) { const unsigned c = xb_ld(&bar[XB_XCNT(j)]); sum += c; cnt += (c > 0u) ? 1u : 0u; mine = (j == x) ? c : mine; }
        if (sum == G) break;
        __builtin_amdgcn_s_sleep(1);
        if ((++sp & 255u) == 0u) { if (xb_ld(&bar[XB_TMO])) break; if (sp > XB_SPIN_CAP) { atomicAdd(&bar[XB_TMO], 1u); break; } }
    }
    nloc = mine > 0u ? mine : 1u; nx = cnt > 0u ? cnt : 1u;
}

__device__ __forceinline__ void xcd_barrier(const XcdBarrier& b) {
    unsigned z_ = 0u; asm volatile("" : "+s"(z_));
    asm volatile("s_waitcnt vmcnt(0)" ::: "memory");
    __syncthreads();
    if (threadIdx.x == 0) {
        unsigned* bar = b.bar + z_; const unsigned bx = b.x + z_;
        __builtin_amdgcn_s_waitcnt(0);
        unsigned nloc = b.st[0], nx = b.st[1];
        if (nloc == 0u) { xcd_barrier_complete(bar, bx, nloc, nx); b.st[0] = nloc; b.st[1] = nx; }
        const unsigned old = xb_add(&bar[XB_XSUB(bx)], 1u);
        const unsigned gen = old / nloc;
        if (old + 1u == (gen + 1u) * nloc) {
            __builtin_amdgcn_fence(__ATOMIC_RELEASE, "agent");
            asm volatile("s_waitcnt vmcnt(0)" ::: "memory");
            const unsigned og = xb_add(&bar[XB_TOP], 1u);
            const unsigned tg = og / nx;
            if (og + 1u == (tg + 1u) * nx) xb_add(&bar[XB_TOPGEN], 1u);
            else XB_SPIN(xb_ld(&bar[XB_TOPGEN]) == tg, bar);
            __builtin_amdgcn_fence(__ATOMIC_ACQUIRE, "agent");
            xb_add(&bar[XB_XGEN(bx)], 1u);
            asm volatile("s_waitcnt vmcnt(0)" ::: "memory");
        } else {
            XB_SPIN(xb_ld(&bar[XB_XGEN(bx)]) == gen, bar);
            __builtin_amdgcn_fence(__ATOMIC_ACQUIRE, "agent");
            asm volatile("s_waitcnt vmcnt(0)" ::: "memory");
        }
    }
    __syncthreads();
}

__device__ __forceinline__ float wave_sum(float v, int lane) {
#pragma unroll
    for (int o = 1; o < 64; o <<= 1) v += __int_as_float(__builtin_amdgcn_ds_bpermute((lane ^ o) << 2, __float_as_int(v)));
    return v;
}
__device__ __forceinline__ void transpose_item(const float* W, int K, int N, bf16* WT, LAS float* scr, int k0, int n0, int drow0, int lane) {
#pragma unroll 8
    for (int i = 0; i < 32; ++i) { const int kk = 2 * i + (lane >> 5); scr[kk * 33 + (lane & 31)] = W[(size_t)(k0 + kk) * N + n0 + (lane & 31)]; }
    LDS_WAIT(); asm volatile("" ::: "memory");
    const int c = lane & 7;
#pragma unroll
    for (int j = 0; j < 4; ++j) { const int n = (lane >> 3) + 8 * j; const LAS float* s = scr + (8 * c) * 33 + n;
        v4u o; o.x = pk2(s[0 * 33], s[1 * 33]); o.y = pk2(s[2 * 33], s[3 * 33]); o.z = pk2(s[4 * 33], s[5 * 33]); o.w = pk2(s[6 * 33], s[7 * 33]);
        *(GAS v4u*)(WT + (size_t)(drow0 + n) * K + k0 + 8 * c) = o; }
    LDS_WAIT(); asm volatile("" ::: "memory");
}
template <bool GU>
__device__ __forceinline__ void transpose_matrix(const float* W, int K, int N, bf16* WT, LAS float* scr, int gw, int NGW, int lane) {
    const int nblk = N / 32, items = (K / 64) * nblk;
    for (int it = gw; it < items; it += NGW) { const int kb = it / nblk, nb = it - kb * nblk, n0 = 32 * nb;
        int drow0 = n0;
        if (GU) { const int half = N / 2; const int nn = n0 < half ? n0 : n0 - half; drow0 = (nn >> 7) * 256 + (nn & 127) + (n0 < half ? 0 : 128); }
        transpose_item(W, K, N, WT, scr, 64 * kb, n0, drow0, lane); }
}
__device__ __forceinline__ void cvt_rows(const float* src, bf16* dstb, float* dstf, int rows, int gw, int NGW, int lane) {
    for (int r = gw; r < rows; r += NGW) { const GAS f32x4* s = (const GAS f32x4*)(src + (size_t)r * DM) + lane;
#pragma unroll
        for (int j = 0; j < 8; ++j) { const f32x4 v = s[64 * j];
            if (dstf) ((GAS f32x4*)(dstf + (size_t)r * DM) + lane)[64 * j] = v;
            v2u w; w.x = pk2(v.x, v.y); w.y = pk2(v.z, v.w); ((GAS v2u*)(dstb + (size_t)r * DM) + lane)[64 * j] = w; } }
}
__device__ __forceinline__ int t5_bucket(int rel) {
    const int n = rel < 0 ? -rel : rel; int b;
    if (n < 8) b = n; else if (n < 12) b = 8; else if (n < 16) b = 9; else if (n < 23) b = 10; else if (n < 32) b = 11; else if (n < 46) b = 12; else if (n < 64) b = 13; else if (n < 91) b = 14; else b = 15;
    return b + (rel > 0 ? 16 : 0);
}
__device__ __forceinline__ void ln_phase(const float* Z, float* X, bf16* XB, const float* g, const float* b, int gw, int NGW, int lane) {
    f32x4 gv[8], bv[8];
#pragma unroll
    for (int j = 0; j < 8; ++j) { gv[j] = ((const GAS f32x4*)g + lane)[64 * j]; bv[j] = ((const GAS f32x4*)b + lane)[64 * j]; }
    for (int r = gw; r < M; r += NGW) { const GAS f32x4* zr = (const GAS f32x4*)(Z + (size_t)r * DM) + lane;
        f32x4 v[8]; float s = 0.f;
#pragma unroll
        for (int j = 0; j < 8; ++j) { v[j] = zr[64 * j]; s += (v[j].x + v[j].y) + (v[j].z + v[j].w); }
        const float mean = wave_sum(s, lane) * (1.f / DM); float s2 = 0.f;
#pragma unroll
        for (int j = 0; j < 8; ++j) { v[j] = v[j] - mean; s2 += (v[j].x * v[j].x + v[j].y * v[j].y) + (v[j].z * v[j].z + v[j].w * v[j].w); }
        const float rstd = 1.f / sqrtf(wave_sum(s2, lane) * (1.f / DM) + LN_EPS);
#pragma unroll
        for (int j = 0; j < 8; ++j) { const f32x4 y = v[j] * rstd * gv[j] + bv[j];
            ((GAS f32x4*)(X + (size_t)r * DM) + lane)[64 * j] = y;
            v2u w; w.x = pk2(y.x, y.y); w.y = pk2(y.z, y.w); ((GAS v2u*)(XB + (size_t)r * DM) + lane)[64 * j] = w; } }
}
__device__ __forceinline__ void rope_phase(bf16* P, const float* qg, const float* kg, const float* cosT, const float* sinT, int gw, int NGW, int lane) {
    const GAS float* qgg = (const GAS float*)qg; const GAS float* kgg = (const GAS float*)kg; const float qg1 = qgg[lane], qg2 = qgg[lane + 64], kg1 = kgg[lane], kg2 = kgg[lane + 64];
    for (int r = gw; r < M; r += NGW) { const int pos = r < 8192 ? (r & 4095) : (r & 2047);
        const float c = cosT[pos * 64 + lane], s = sinT[pos * 64 + lane];
#pragma unroll
        for (int hh = 0; hh < 10; ++hh) { bf16* p = P + (size_t)r * INW + (hh < 8 ? C_QC + hh * 128 : C_KC + (hh - 8) * 128) + lane;
            float x1 = bf2f(p[0]), x2 = bf2f(p[64]);
            const float ss = wave_sum(x1 * x1 + x2 * x2, lane), rr = 1.f / sqrtf(ss * (1.f / 128.f) + RMS_EPS);
            x1 = x1 * rr * (hh < 8 ? qg1 : kg1); x2 = x2 * rr * (hh < 8 ? qg2 : kg2);
            const float y1 = x1 * c - x2 * s, y2 = x1 * s + x2 * c;
            p[0] = (bf16)(pk2(y1, 0.f) & 0xffffu); p[64] = (bf16)(pk2(y2, 0.f) & 0xffffu); } }
}
__device__ __forceinline__ void diffcomb_phase(const float* O12, bf16* YS0, const float* lamqk, const float* subg, int layer, int gw, int NGW, int lane) {
    float c08 = 0.8f; asm volatile("" : "+v"(c08)); const GAS float* lamg = (const GAS float*)lamqk;
    const float linit = c08 - 0.6f * __expf(-0.3f * (float)layer);
    const float d1 = wave_sum(lamg[lane] * lamg[128 + lane] + lamg[64 + lane] * lamg[192 + lane], lane);
    const float d2 = wave_sum(lamg[256 + lane] * lamg[384 + lane] + lamg[320 + lane] * lamg[448 + lane], lane);
    const float lam = __expf(d1) - __expf(d2) + linit;
    const f32x4 g = ((const GAS f32x4*)subg)[lane];
    for (int it = gw; it < M * 4; it += NGW) { const int r = it >> 2, h = it & 3;
        const f32x4 o1 = ((const GAS f32x4*)(O12 + (size_t)r * 1024 + h * 256))[lane], o2 = ((const GAS f32x4*)(O12 + (size_t)M * 1024 + (size_t)r * 1024 + h * 256))[lane];
        const f32x4 d = o1 - o2 * lam;
        const float ss = wave_sum((d.x * d.x + d.y * d.y) + (d.z * d.z + d.w * d.w), lane);
        const float rr = (1.f - linit) / sqrtf(ss * (1.f / 256.f) + RMS_EPS);
        const f32x4 y = d * rr * g;
        v2u w; w.x = pk2(y.x, y.y); w.y = pk2(y.z, y.w); ((GAS v2u*)(YS0 + (size_t)r * 1024 + h * 256))[lane] = w; }
}


struct Args { const float* in[19]; float* out; unsigned char* ws; int ph_lo, ph_hi, li, pad; };
enum { I_XP = 0, I_XS, I_MP, I_MS, I_RBT, I_WIN, I_WBR, I_WOUT, I_LAMQK, I_SUBG, I_SINK, I_QKG, I_WMQ, I_WMKV, I_WMO, I_WGU, I_WD, I_LNG, I_LNB };

constexpr size_t WS_PT = WS_BT + 16384;
__device__ __forceinline__ int tid_fresh() { int t = threadIdx.x; asm volatile("" : "+v"(t)); return t; }
template <class T> __device__ __forceinline__ T* as_global(T* p) { return (T*)(GAS T*)p; }
#define PHASE_PROLOG() unsigned zo_ = 0u; asm volatile("" : "+s"(zo_)); unsigned char* wsp = ws + zo_; const float* const* IN = (const float* const*)(wsp + WS_PT); \
    const int tid = tid_fresh(), lane = tid & 63, wave = __builtin_amdgcn_readfirstlane(tid >> 6), gw = bid * NWAVES + wave; (void)lane; (void)gw; (void)IN
#define WSP(T, off) ((T*)(wsp + (off)))

__global__ void __launch_bounds__(NWAVES * 64, 2) fwd(Args args) {
    extern __shared__ __attribute__((aligned(16))) unsigned char lds[];
    LAS unsigned char* ldsl = (LAS unsigned char*)lds;
    volatile LAS unsigned* MISC = (volatile LAS unsigned*)(ldsl + MISC_OFF);
    const int G = gridDim.x, bid = blockIdx.x, NGW = G * NWAVES;
    unsigned char* ws = args.ws;
    unsigned* ctl = (unsigned*)(ws + WS_CTL);
    { const int t0 = tid_fresh(); for (int u = t0; u < (LDS_BYTES - LDSCTL_OFF) / 4; u += NWAVES * 64) ((LAS unsigned*)(ldsl + LDSCTL_OFF))[u] = 0u; }
    __syncthreads();
    const int lo = args.ph_lo, hi = args.ph_hi;
    const bool use_bar = (hi - lo) > 1;
    XcdBarrier bar; bar.bar = ctl + CW_BAR + args.li * XCD_BAR_WORDS; bar.x = 0; bar.st = nullptr;
    if (use_bar) bar = xcd_barrier_post(ctl + CW_BAR + args.li * XCD_BAR_WORDS, MISC + 8);
    int ph = 0;
#define PH_ON (ph >= lo && ph < hi)
#define SEAM() do { ++ph; if (ph > lo && ph < hi) xcd_barrier(bar); } while (0)

    if (PH_ON) {
        unsigned char* wsp = ws; const int tid = tid_fresh(), lane = tid & 63, wave = __builtin_amdgcn_readfirstlane(tid >> 6), gw = bid * NWAVES + wave;
        if (bid == 0 && tid == 0) { const float** PT = WSP(const float*, WS_PT);
#pragma unroll
            for (int i = 0; i < 19; ++i) PT[i] = args.in[i];
            PT[19] = args.out; }
        LAS float* scr = (LAS float*)(ldsl + wave * 16384);
        for (int l = 0; l < DEPTH; ++l) {
            transpose_matrix<false>(args.in[I_WIN] + (size_t)l * DM * INW, DM, INW, WSP(bf16, WS_WIN + l * SZ_WIN), scr, gw, NGW, lane);
            for (int n = 0; n < 3; ++n) transpose_matrix<false>(args.in[I_WBR] + (size_t)(l * 3 + n) * 1024 * DM, 1024, DM, WSP(bf16, WS_WBR + l * SZ_WBR) + (size_t)n * DM * 1024, scr, gw, NGW, lane);
            transpose_matrix<false>(args.in[I_WOUT] + (size_t)l * DM * DM, DM, DM, WSP(bf16, WS_WOUT + l * SZ_WOUT), scr, gw, NGW, lane);
            transpose_matrix<false>(args.in[I_WMQ] + (size_t)l * DM * MEMI, DM, MEMI, WSP(bf16, WS_WMQ + l * SZ_WMQ), scr, gw, NGW, lane);
            transpose_matrix<false>(args.in[I_WMKV] + (size_t)l * DM * 1024, DM, 1024, WSP(bf16, WS_WMKV + l * SZ_WMKV), scr, gw, NGW, lane);
            transpose_matrix<false>(args.in[I_WMO] + (size_t)l * MEMI * DM, MEMI, DM, WSP(bf16, WS_WMO + l * SZ_WMO), scr, gw, NGW, lane);
            for (int f = 0; f < 2; ++f) {
                transpose_matrix<true>(args.in[I_WGU] + (size_t)(l * 2 + f) * DM * 2 * DFF, DM, 2 * DFF, WSP(bf16, WS_WGU + (l * 2 + f) * SZ_WGU), scr, gw, NGW, lane);
                transpose_matrix<false>(args.in[I_WD] + (size_t)(l * 2 + f) * DFF * DM, DFF, DM, WSP(bf16, WS_WD + (l * 2 + f) * SZ_WD), scr, gw, NGW, lane);
            }
        }
        cvt_rows(args.in[I_XP], WSP(bf16, WS_XB), args.out, 8192, gw, NGW, lane);
        cvt_rows(args.in[I_XS], WSP(bf16, WS_XB) + (size_t)8192 * DM, args.out + (size_t)8192 * DM, 8192, gw, NGW, lane);
        cvt_rows(args.in[I_MP], WSP(bf16, WS_MEMB), nullptr, 512, gw, NGW, lane);
        cvt_rows(args.in[I_MS], WSP(bf16, WS_MEMB) + (size_t)512 * DM, nullptr, 1024, gw, NGW, lane);
        const int gt = bid * NWAVES * 64 + tid, NGT = G * NWAVES * 64;
        float* BT = WSP(float, WS_BT); float* COS = WSP(float, WS_COS); float* SIN = WSP(float, WS_SIN);
        for (int i = gt; i < 12 * att::TBL_PITCH; i += NGT) { const int hd = i / att::TBL_PITCH, k = i - hd * att::TBL_PITCH; const int rel = k - 129, n = rel < 0 ? -rel : rel;
            float v = 0.f;
            if (k < att::TBL_N) { if (hd >= 4 && n > 128) v = -1e30f / att::SCALE; else v = args.in[I_RBT][t5_bucket(rel) * 12 + hd] * (1.0f / att::SCALE); }
            BT[i] = v; }
        for (int i = gt; i < 4096 * 64; i += NGT) { const int pos = i >> 6, jj = i & 63; const int f = jj & 31;
            const float inv = __builtin_amdgcn_exp2f(-(float)f * (13.287712379549449f / 32.0f));
            const float ang = (float)(jj < 32 ? (pos >> 6) : (pos & 63)) * inv;
            COS[i] = __cosf(ang); SIN[i] = __sinf(ang); }
    }
    SEAM();
    if (PH_ON) { PHASE_PROLOG();
        pg8::Gemm g{WSP(bf16, WS_MEMB), WSP(bf16, WS_WMKV), MEMROWS, 4096, DM}; pg8::StaticOrder S; S.init(MEMROWS, 4096, G, bid);
        pg8::EpiBf16 E{WSP(bf16, WS_MKV), 4096, 1 << 30};
        pg8::gemm_phase<pg8::EpiBf16, pg8::StaticOrder, true, true>(ldsl, g, S, E);
    }
    SEAM();

    for (int j = 0; j < 2 * DEPTH; ++j) {
        const int l = j >> 1;
        if (PH_ON) { PHASE_PROLOG();
            pg8::Gemm g{WSP(bf16, WS_XB), WSP(bf16, WS_WGU + j * SZ_WGU), M, 2 * DFF, DM}; pg8::StaticOrder S; S.init(M, 2 * DFF, G, bid);
            pg8::EpiSwiGLU E{WSP(bf16, WS_H), DFF};
            pg8::gemm_phase<pg8::EpiSwiGLU, pg8::StaticOrder, true, true>(ldsl, g, S, E);
        }
        SEAM();
        if (PH_ON) { PHASE_PROLOG();
            pg8::Gemm g{WSP(bf16, WS_H), WSP(bf16, WS_WD + j * SZ_WD), M, DM, DFF}; pg8::StaticOrder S; S.init(M, DM, G, bid);
            pg8::EpiResid E{as_global(IN[19]), WSP(float, WS_Z), DM, ALPHA, 0.5f};
            pg8::gemm_phase<pg8::EpiResid, pg8::StaticOrder, true, true>(ldsl, g, S, E);
        }
        SEAM();
        if (PH_ON) { PHASE_PROLOG(); const int li = l * 4 + ((j & 1) ? 3 : 0); ln_phase(WSP(float, WS_Z), as_global((float*)IN[19]), WSP(bf16, WS_XB), as_global(IN[I_LNG]) + li * DM, as_global(IN[I_LNB]) + li * DM, gw, NGW, lane); }
        SEAM();
        if (!(j & 1)) {
            if (PH_ON) { PHASE_PROLOG();
                pg8::Gemm g{WSP(bf16, WS_XB), WSP(bf16, WS_WIN + l * SZ_WIN), M, INW, DM}; pg8::StaticOrder S; S.init(M, INW, G, bid);
                pg8::EpiBf16 E{WSP(bf16, WS_P), INW, C_GATE / 256};
                pg8::gemm_phase<pg8::EpiBf16, pg8::StaticOrder, true, true>(ldsl, g, S, E);
            }
            SEAM();
            if (PH_ON) { PHASE_PROLOG(); rope_phase(WSP(bf16, WS_P), as_global(IN[I_QKG]) + l * 256, as_global(IN[I_QKG]) + l * 256 + 128, WSP(float, WS_COS), WSP(float, WS_SIN), gw, NGW, lane); }
            SEAM();
            if (PH_ON) { PHASE_PROLOG();
                volatile LAS int* qs = (volatile LAS int*)(ldsl + att::OFF_Q);
                unsigned* qhead = WSP(unsigned, WS_CTL) + CW_Q + 64 * l;
                bf16* P = WSP(bf16, WS_P); float* O12 = WSP(float, WS_O12); bf16* YS = WSP(bf16, WS_YS); const float* BT = WSP(float, WS_BT);
                for (;;) {
                    if (tid == 0) *qs = (int)__hip_atomic_fetch_add(qhead, 1u, __ATOMIC_RELAXED, __HIP_MEMORY_SCOPE_AGENT);
                    __syncthreads();
                    const int u = __builtin_amdgcn_readfirstlane(*qs);
                    __syncthreads();
                    if (u >= 2048) break;
                    att::UnitP U; int row0, seq0, S_, q0;
                    U.mode = 0; U.tbl = BT; U.sink_l2 = -__builtin_inff(); U.obf = 1;
                    if (u < 1536) {
                        int t, prompt, dif;
                        if (u < 512) { t = u; prompt = 1; dif = 1; } else if (u < 768) { t = u - 512; prompt = 1; dif = 0; } else if (u < 1280) { t = u - 768; prompt = 0; dif = 1; } else { t = u - 1280; prompt = 0; dif = 0; }
                        const int qb = prompt ? (t & 15) : (t & 7); t >>= (prompt ? 4 : 3);
                        S_ = prompt ? 4096 : 2048; q0 = qb * 256;
                        if (dif) { const int vh = t & 1, m = (t >> 1) & 1, h = (t >> 2) & 3, b = t >> 4;
                            seq0 = prompt ? b * 4096 : 8192 + b * 2048; row0 = seq0 + q0;
                            U.Q = P + (size_t)row0 * INW + C_QA + (2 * h + m) * 128; U.K = P + (size_t)seq0 * INW + C_KA + (2 * h + m) * 128; U.V = P + (size_t)seq0 * INW + C_VA + (2 * h + vh) * 128;
                            U.O = O12 + (size_t)m * M * 1024 + (size_t)row0 * 1024 + (2 * h + vh) * 128; U.obf = 0; U.mode = 1; U.tbl = BT + h * att::TBL_PITCH;
                        } else { const int head = t & 7, b = t >> 3;
                            seq0 = prompt ? b * 4096 : 8192 + b * 2048; row0 = seq0 + q0;
                            U.Q = P + (size_t)row0 * INW + C_QC + head * 128; U.K = P + (size_t)seq0 * INW + C_KC + (head >> 2) * 128; U.V = P + (size_t)seq0 * INW + C_VC + (head >> 2) * 128;
                            U.O = YS + (size_t)2 * M * 1024 + (size_t)row0 * 1024 + head * 128; }
                        U.nt = S_ / 64; U.rel0 = -q0;
                    } else { const int t = u - 1536, head = t & 7, qbg = t >> 3;
                        if (qbg < 32) { S_ = 4096; seq0 = (qbg >> 4) * 4096; q0 = (qbg & 15) * 256; } else { S_ = 2048; seq0 = 8192 + ((qbg - 32) >> 3) * 2048; q0 = ((qbg - 32) & 7) * 256; }
                        row0 = seq0 + q0;
                        const int k0 = q0 >= 128 ? q0 - 128 : 0, k1 = (q0 + 384 < S_) ? q0 + 384 : S_;
                        U.Q = P + (size_t)row0 * INW + C_QB + head * 128; U.K = P + (size_t)(seq0 + k0) * INW + C_KB + (head >> 2) * 128; U.V = P + (size_t)(seq0 + k0) * INW + C_VB + (head >> 2) * 128;
                        U.O = YS + (size_t)1 * M * 1024 + (size_t)row0 * 1024 + head * 128; U.mode = 2; U.tbl = BT + (4 + head) * att::TBL_PITCH;
                        U.sink_l2 = ((const GAS float*)IN[I_SINK])[l * 8 + head] * 1.4426950408889634f;
                        U.nt = (k1 - k0) / 64; U.rel0 = k0 - q0; }
                    att::attn_unit<INW, INW, 1024, true>(U, (char*)lds);
                }
            }
            SEAM();
            if (PH_ON) { PHASE_PROLOG(); diffcomb_phase(WSP(float, WS_O12), WSP(bf16, WS_YS), as_global(IN[I_LAMQK]) + l * 512, as_global(IN[I_SUBG]) + l * 256, l, gw, NGW, lane); }
            SEAM();
            if (PH_ON) { PHASE_PROLOG();
                pg8::Gemm g{WSP(bf16, WS_YS), WSP(bf16, WS_WBR + l * SZ_WBR), 3 * M, 3 * DM, 1024}; pg8::BranchOrder S; S.init(G, bid);
                pg8::EpiBranch E{WSP(bf16, WS_P) + C_GATE, INW, WSP(bf16, WS_MG), DM};
                pg8::gemm_phase<pg8::EpiBranch, pg8::BranchOrder, true, true>(ldsl, g, S, E);
            }
            SEAM();
            if (PH_ON) { PHASE_PROLOG();
                pg8::Gemm g{WSP(bf16, WS_MG), WSP(bf16, WS_WOUT + l * SZ_WOUT), M, DM, DM}; pg8::StaticOrder S; S.init(M, DM, G, bid);
                pg8::EpiResid E{as_global(IN[19]), WSP(float, WS_Z), DM, ALPHA, 1.0f};
                pg8::gemm_phase<pg8::EpiResid, pg8::StaticOrder, true, true>(ldsl, g, S, E);
            }
            SEAM();
            if (PH_ON) { PHASE_PROLOG(); const int li = l * 4 + 1; ln_phase(WSP(float, WS_Z), as_global((float*)IN[19]), WSP(bf16, WS_XB), as_global(IN[I_LNG]) + li * DM, as_global(IN[I_LNB]) + li * DM, gw, NGW, lane); }
            SEAM();
            if (PH_ON) { PHASE_PROLOG();
                pg8::Gemm g{WSP(bf16, WS_XB), WSP(bf16, WS_WMQ + l * SZ_WMQ), M, MEMI, DM}; pg8::StaticOrder S; S.init(M, MEMI, G, bid);
                pg8::EpiBf16 E{WSP(bf16, WS_MQ), MEMI, 1 << 30};
                pg8::gemm_phase<pg8::EpiBf16, pg8::StaticOrder, true, true>(ldsl, g, S, E);
            }
            SEAM();
            if (PH_ON) { PHASE_PROLOG();
                bf16* MQ = WSP(bf16, WS_MQ); bf16* MKV = WSP(bf16, WS_MKV); bf16* MO = WSP(bf16, WS_MO);
                for (int u = bid; u < 256; u += G) { const int head = u & 3, qbg = u >> 2;
                    const int ms = qbg < 32 ? (qbg >> 4) : 2 + ((qbg - 32) >> 3);
                    att::UnitP U; U.mode = 0; U.tbl = nullptr; U.sink_l2 = -__builtin_inff(); U.obf = 1; U.nt = 4; U.rel0 = 0;
                    U.Q = MQ + (size_t)qbg * 256 * MEMI + head * 128; U.K = MKV + (size_t)ms * 256 * 4096 + l * 1024 + head * 128; U.V = U.K + 512;
                    U.O = MO + (size_t)qbg * 256 * MEMI + head * 128;
                    att::attn_unit<MEMI, 4096, MEMI, false>(U, (char*)lds);
                }
            }
            SEAM();
            if (PH_ON) { PHASE_PROLOG();
                pg8::Gemm g{WSP(bf16, WS_MO), WSP(bf16, WS_WMO + l * SZ_WMO), M, DM, MEMI}; pg8::StaticOrder S; S.init(M, DM, G, bid);
                pg8::EpiResid E{as_global(IN[19]), WSP(float, WS_Z), DM, ALPHA, 1.0f};
                pg8::gemm_phase<pg8::EpiResid, pg8::StaticOrder, true, true>(ldsl, g, S, E);
            }
            SEAM();
            if (PH_ON) { PHASE_PROLOG(); const int li = l * 4 + 2; ln_phase(WSP(float, WS_Z), as_global((float*)IN[19]), WSP(bf16, WS_XB), as_global(IN[I_LNG]) + li * DM, as_global(IN[I_LNB]) + li * DM, gw, NGW, lane); }
            SEAM();
        }
    }
#undef PH_ON
#undef SEAM
}
constexpr int N_PHASES = 2 + 8 * 3 + 4 * 11;

extern "C" void kernel_launch(void* const* d_in, const int* in_sizes, int n_in, void* d_out, int out_size, void* d_ws, size_t ws_size, hipStream_t stream) {
    static int grid = 0;
    if (grid == 0) {
        if (n_in != 19 || out_size != M * DM || ws_size < WS_END) { fprintf(stderr, "kernel_launch: unexpected shapes: n_in %d out %d ws %zu (need %zu)\n", n_in, out_size, ws_size, (size_t)WS_END); grid = -1; return; }
        int dev = 0, cus = 0, per_cu = 0;
        if (hipGetDevice(&dev) != hipSuccess || hipDeviceGetAttribute(&cus, hipDeviceAttributeMultiprocessorCount, dev) != hipSuccess) { fprintf(stderr, "kernel_launch: device query failed\n"); grid = -1; return; }
        if (hipFuncSetAttribute((const void*)fwd, hipFuncAttributeMaxDynamicSharedMemorySize, LDS_BYTES) != hipSuccess) { fprintf(stderr, "kernel_launch: hipFuncSetAttribute failed\n"); grid = -1; return; }
        if (hipOccupancyMaxActiveBlocksPerMultiprocessor(&per_cu, (const void*)fwd, NWAVES * 64, LDS_BYTES) != hipSuccess || per_cu < 1)
            fprintf(stderr, "kernel_launch: note: occupancy query reports %d workgroups per CU\n", per_cu);
        (void)hipGetLastError();
        grid = cus;
    }
    if (grid < 0) return;
    if (hipMemsetAsync((char*)d_ws + WS_CTL, 0, CTL_ZERO_BYTES, stream) != hipSuccess) { fprintf(stderr, "kernel_launch: memset failed\n"); return; }
    Args a{};
    for (int i = 0; i < 19; ++i) a.in[i] = (const float*)d_in[i];
    a.out = (float*)d_out; a.ws = (unsigned char*)d_ws; a.pad = 0;
#if MK_ONE_LAUNCH
    a.ph_lo = 0; a.ph_hi = N_PHASES; a.li = 0;
    hipLaunchKernelGGL(fwd, dim3(grid), dim3(NWAVES * 64), LDS_BYTES, stream, a);
#else
    for (int p = 0; p < N_PHASES; ++p) { a.ph_lo = p; a.ph_hi = p + 1; a.li = 0;
        hipLaunchKernelGGL(fwd, dim3(grid), dim3(NWAVES * 64), LDS_BYTES, stream, a); }
#endif
    const hipError_t le = hipPeekAtLastError();
    if (le != hipSuccess) fprintf(stderr, "kernel_launch: launch failed: %s\n", hipGetErrorName(le));
}
```

```cpp
#include <hip/hip_runtime.h>
#include <cstdio>
#include <cstdint>

#ifndef MK_ONE_LAUNCH
#define MK_ONE_LAUNCH 1
#endif

namespace pg8 {
#define PG8_LAS __attribute__((address_space(3)))
typedef unsigned short bf16_t;
typedef short bf16x8 __attribute__((ext_vector_type(8)));
typedef float f32x4 __attribute__((ext_vector_type(4)));
typedef unsigned u32x4 __attribute__((ext_vector_type(4)));
constexpr int BM = 256, BK = 64, HALF = 128, HTB = HALF * BK * 2  , STAGE_BYTES = 8 * HTB, NXCD = 8, WGM = 8;

__host__ __device__ __forceinline__ int lds_byte(int r, int c) { const int st = (r >> 4) * 2 + (c >> 5), rr = r & 15, cc = c & 31, ob = rr * 64 + cc * 2; return st * 1024 + (ob ^ (((ob >> 9) & 1) << 5)); }
__host__ __device__ __forceinline__ void stage_rc(int b, int& R, int& C) { const int st = b / 1024, sb = b % 1024, swz = sb ^ (((sb >> 9) & 1) << 5); R = (st >> 1) * 16 + swz / 64; C = (st & 1) * 32 + (swz % 64) / 2; }
__host__ __device__ __forceinline__ int perm32(int rho) { const int n = rho >> 4, i = rho & 15; return 8 * (i >> 2) + 4 * n + (i & 3); }

struct Unit { int pm, pn; };
struct Gemm { const bf16_t* A; const bf16_t* Bt; int M, N, K; };

struct StaticOrder {
    int nM, nN, nwg, G, c;
    __host__ __device__ void init(int M, int N, int G_, int c_) { nM = M / BM; nN = N / BM; nwg = nM * nN; G = G_; c = c_; }
    __host__ __device__ bool next(int i, Unit& u) const {
        const long L = (long)i * G + c; if (L >= nwg) return false;
        int wgid = (int)L; { const int q = nwg / NXCD, r = nwg % NXCD, xcd = wgid % NXCD, off = wgid / NXCD; wgid = (xcd < r ? xcd * (q + 1) : r * (q + 1) + (xcd - r) * q) + off; }
        const int nig = WGM * nN, gid = wgid / nig, fm = gid * WGM, gsz = (nM - fm) < WGM ? (nM - fm) : WGM;
        u.pm = fm + ((wgid % nig) % gsz); u.pn = (wgid % nig) / gsz; return true;
    }
    __device__ __forceinline__ void a_ready(const Unit&) const {}
    __device__ __forceinline__ void done(const Unit&) const {}
};

__device__ __forceinline__ unsigned cvt_pk_bf16(float lo, float hi) { unsigned r; asm volatile("v_cvt_pk_bf16_f32 %0, %1, %2" : "=v"(r) : "v"(lo), "v"(hi)); return r; }
__device__ __forceinline__ float bf_lo(unsigned w) { return __uint_as_float(w << 16); }
__device__ __forceinline__ float bf_hi(unsigned w) { return __uint_as_float(w & 0xffff0000u); }
__device__ __forceinline__ float sigmoidf_fast(float v) { return __builtin_amdgcn_rcpf(1.0f + __builtin_amdgcn_exp2f(-1.4426950408889634f * v)); }

struct EpiSwiGLU {
    static constexpr bool PERM = true, AFTER_DRAIN = false;
    bf16_t* H; int ldh;
    __device__ __forceinline__ bool zero_after(const Unit&) const { return true; }
    __device__ __forceinline__ void operator()(f32x4 (&acc)[2][2][4][2], const Unit& u, int wr, int wc, int fr, int fq) const {
        const int row0 = u.pm * BM + wr * 64 + fr, col0 = u.pn * HALF + wc * 32 + 8 * fq;
#pragma unroll
        for (int ai = 0; ai < 2; ++ai)
#pragma unroll
            for (int m = 0; m < 4; ++m) { bf16_t* rowp = H + (size_t)(row0 + ai * HALF + m * 16) * ldh + col0;
                float hv[8];
#pragma unroll
                for (int n = 0; n < 2; ++n)
#pragma unroll
                    for (int j = 0; j < 4; ++j) { const float g = acc[ai][0][m][n][j], uu = acc[ai][1][m][n][j]; hv[n * 4 + j] = g * sigmoidf_fast(g) * uu; }
                u32x4 w; w.x = cvt_pk_bf16(hv[0], hv[1]); w.y = cvt_pk_bf16(hv[2], hv[3]); w.z = cvt_pk_bf16(hv[4], hv[5]); w.w = cvt_pk_bf16(hv[6], hv[7]);
                *(u32x4*)rowp = w; }
    }
};
struct EpiResid {
    static constexpr bool PERM = false, AFTER_DRAIN = false;
    const float* X; float* Z; int ldc; float alpha, s;
    __device__ __forceinline__ bool zero_after(const Unit&) const { return true; }
    __device__ __forceinline__ void operator()(f32x4 (&acc)[2][2][4][2], const Unit& u, int wr, int wc, int fr, int fq) const {
        const int row0 = u.pm * BM + wr * 64 + fr, col0 = u.pn * BM + wc * 32 + 4 * fq;
#pragma unroll
        for (int ai = 0; ai < 2; ++ai)
#pragma unroll
            for (int m = 0; m < 4; ++m) { const size_t off = (size_t)(row0 + ai * HALF + m * 16) * ldc + col0;
#pragma unroll
                for (int bj = 0; bj < 2; ++bj)
#pragma unroll
                    for (int n = 0; n < 2; ++n) { const f32x4 xv = *(const __attribute__((address_space(1))) f32x4*)(X + off + bj * HALF + n * 16);
                        *(__attribute__((address_space(1))) f32x4*)(Z + off + bj * HALF + n * 16) = xv * alpha + acc[ai][bj][m][n] * s; } }
    }
};
struct EpiBf16 {
    static constexpr bool PERM = true, AFTER_DRAIN = false;
    bf16_t* O; int ldc; int sig_from;
    __device__ __forceinline__ bool zero_after(const Unit&) const { return true; }
    __device__ __forceinline__ void operator()(f32x4 (&acc)[2][2][4][2], const Unit& u, int wr, int wc, int fr, int fq) const {
        const int row0 = u.pm * BM + wr * 64 + fr, col0 = u.pn * BM + wc * 32 + 8 * fq;
        const bool sg = u.pn >= sig_from;
#pragma unroll
        for (int ai = 0; ai < 2; ++ai)
#pragma unroll
            for (int m = 0; m < 4; ++m) { bf16_t* rowp = O + (size_t)(row0 + ai * HALF + m * 16) * ldc + col0;
#pragma unroll
                for (int bj = 0; bj < 2; ++bj) { f32x4 v0 = acc[ai][bj][m][0], v1 = acc[ai][bj][m][1];
                    if (sg) {
#pragma unroll
                        for (int j = 0; j < 4; ++j) { v0[j] = sigmoidf_fast(v0[j]); v1[j] = sigmoidf_fast(v1[j]); } }
                    u32x4 w; w.x = cvt_pk_bf16(v0[0], v0[1]); w.y = cvt_pk_bf16(v0[2], v0[3]); w.z = cvt_pk_bf16(v1[0], v1[1]); w.w = cvt_pk_bf16(v1[2], v1[3]);
                    *(u32x4*)(rowp + bj * HALF) = w; } }
    }
};
struct EpiBranch {
    static constexpr bool PERM = true, AFTER_DRAIN = false;
    const bf16_t* G; int ldg;
    bf16_t* O; int ldc;
    __device__ __forceinline__ bool zero_after(const Unit& u) const { return (u.pm >> 6) == 2; }
    __device__ __forceinline__ void operator()(f32x4 (&acc)[2][2][4][2], const Unit& u, int wr, int wc, int fr, int fq) const {
        const int nb = u.pm >> 6, pm = u.pm & 63, pn = u.pn & 7;
        const int row0 = pm * BM + wr * 64 + fr, col0 = pn * BM + wc * 32 + 8 * fq;
#pragma unroll
        for (int ai = 0; ai < 2; ++ai)
#pragma unroll
            for (int m = 0; m < 4; ++m) { const size_t r = (size_t)(row0 + ai * HALF + m * 16);
#pragma unroll
                for (int bj = 0; bj < 2; ++bj) {
                    const u32x4 ga = *(const u32x4*)(G + r * ldg + nb * 2048 + col0 + bj * HALF);
                    float f[8] = {bf_lo(ga.x), bf_hi(ga.x), bf_lo(ga.y), bf_hi(ga.y), bf_lo(ga.z), bf_hi(ga.z), bf_lo(ga.w), bf_hi(ga.w)};
                    if (nb < 2) { const u32x4 gb = *(const u32x4*)(G + r * ldg + (nb + 1) * 2048 + col0 + bj * HALF);
                        const float d[8] = {bf_lo(gb.x), bf_hi(gb.x), bf_lo(gb.y), bf_hi(gb.y), bf_lo(gb.z), bf_hi(gb.z), bf_lo(gb.w), bf_hi(gb.w)};
#pragma unroll
                        for (int j = 0; j < 8; ++j) f[j] = f[j] * __builtin_amdgcn_rcpf(fmaxf(d[j], 1e-30f));
                    }
#pragma unroll
                    for (int j = 0; j < 4; ++j) { acc[ai][bj][m][0][j] *= f[j]; acc[ai][bj][m][1][j] *= f[4 + j]; }
                    if (nb == 2) { const f32x4 v0 = acc[ai][bj][m][0], v1 = acc[ai][bj][m][1];
                        u32x4 w; w.x = cvt_pk_bf16(v0[0], v0[1]); w.y = cvt_pk_bf16(v0[2], v0[3]); w.z = cvt_pk_bf16(v1[0], v1[1]); w.w = cvt_pk_bf16(v1[2], v1[3]);
                        *(u32x4*)(O + r * ldc + col0 + bj * HALF) = w; } } }
    }
};
struct BranchOrder {
    StaticOrder so;
    __device__ void init(int G_, int c_) { so.init(16384, 2048, G_, c_); }
    __device__ bool next(int i, Unit& u) const { Unit t; if (!so.next(i / 3, t)) return false; const int n = i % 3; u.pm = n * 64 + t.pm; u.pn = n * 8 + t.pn; return true; }
    __device__ __forceinline__ void a_ready(const Unit&) const {}
    __device__ __forceinline__ void done(const Unit&) const {}
};

template <class Epi, class Sched, bool ALIGN_EPI = false, bool SP2 = false>
__device__ __forceinline__ void gemm_phase(PG8_LAS unsigned char* lds, const Gemm g, const Sched& S, const Epi& E) {
    int tid = threadIdx.x; asm volatile("" : "+v"(tid)); const int wid = __builtin_amdgcn_readfirstlane(tid >> 6), lane = tid & 63, wr = wid >> 2, wc = wid & 3, fr = lane & 15, fq = lane >> 4;
    const int K = g.K, nt = K / BK;
    unsigned voffA[2], voffB[2];
#pragma unroll
    for (int i = 0; i < 2; ++i) { int R, C; stage_rc(tid * 16 + i * 8192, R, C); const int Rb = Epi::PERM ? ((R & ~31) + perm32(R & 31)) : R;
        voffA[i] = (unsigned)(R * K + C) * 2u; voffB[i] = (unsigned)(Rb * K + C) * 2u; }
    const size_t kstep = (size_t)(BK * 2);
    const size_t hstep = (size_t)HALF * K * 2;
    const size_t tstep = 2 * hstep;
    const unsigned ldsw = (unsigned)wid * 1024u;
    const int aoff = lds_byte(wr * 64 + fr, fq * 8), boff = lds_byte(wc * 32 + fr, fq * 8);
#define PG8_SA(b, h) (((b) * 2 + (h)) * HTB)
#define PG8_SB(b, h) ((4 + (b) * 2 + (h)) * HTB)
#define PG8_STAGE(bufoff, gbase, voff) do { _Pragma("unroll") for (int _i = 0; _i < 2; ++_i) \
        __builtin_amdgcn_global_load_lds((const unsigned*)((const char*)(gbase) + (voff)[_i]), (PG8_LAS unsigned*)(lds + (bufoff) + ldsw + _i * 8192), 16, 0, 0); } while (0)
#define PG8_LDA(dst, b, h) do { _Pragma("unroll") for (int m = 0; m < 4; ++m) _Pragma("unroll") for (int k = 0; k < 2; ++k) dst[m][k] = *(const PG8_LAS bf16x8*)(lds + PG8_SA(b, h) + aoff + m * 2048 + k * 1024); } while (0)
#define PG8_LDB(dst, b, h) do { _Pragma("unroll") for (int n = 0; n < 2; ++n) _Pragma("unroll") for (int k = 0; k < 2; ++k) dst[n][k] = *(const PG8_LAS bf16x8*)(lds + PG8_SB(b, h) + boff + n * 2048 + k * 1024); } while (0)
#define PG8_MMA(ai, bj, At, Bt) do { __builtin_amdgcn_s_setprio(1); _Pragma("unroll") for (int m = 0; m < 4; ++m) _Pragma("unroll") for (int n = 0; n < 2; ++n) _Pragma("unroll") for (int k = 0; k < 2; ++k) \
        acc[ai][bj][m][n] = __builtin_amdgcn_mfma_f32_16x16x32_bf16(Bt[n][k], At[m][k], acc[ai][bj][m][n], 0, 0, 0); __builtin_amdgcn_s_setprio(0); } while (0)
#define PG8_WAIT_V(n) asm volatile("s_waitcnt vmcnt(" #n ")" ::: "memory")
#define PG8_WAIT_L(n) asm volatile("s_waitcnt lgkmcnt(" #n ")" ::: "memory")
#define PG8_BAR __builtin_amdgcn_s_barrier()
#define PG8_SCHED __builtin_amdgcn_sched_barrier(0)
    Unit cur, nxt; int ui = 0;
    if (!S.next(0, cur)) return;
    f32x4 acc[2][2][4][2];
#pragma unroll
    for (int a = 0; a < 2; ++a)
#pragma unroll
        for (int b = 0; b < 2; ++b)
#pragma unroll
            for (int m = 0; m < 4; ++m)
#pragma unroll
                for (int n = 0; n < 2; ++n) acc[a][b][m][n] = (f32x4){0.f, 0.f, 0.f, 0.f};
    bf16x8 At[4][2], B0[2][2], B1[2][2];
    const char* cA = (const char*)g.A + (size_t)cur.pm * tstep; const char* cB = (const char*)g.Bt + (size_t)cur.pn * tstep;
    S.a_ready(cur);
    if constexpr (SP2) {
        PG8_STAGE(PG8_SB(0, 0), cB, voffB); PG8_STAGE(PG8_SB(0, 1), cB + hstep, voffB); PG8_STAGE(PG8_SA(0, 0), cA, voffA); PG8_STAGE(PG8_SA(0, 1), cA + hstep, voffA);
        if (wr == 1) PG8_BAR;
        PG8_WAIT_V(2); PG8_BAR;
        PG8_STAGE(PG8_SB(1, 0), cB + kstep, voffB); PG8_STAGE(PG8_SA(1, 0), cA + kstep, voffA); PG8_STAGE(PG8_SB(1, 1), cB + hstep + kstep, voffB);
        PG8_WAIT_V(6); PG8_BAR;
    } else {
        PG8_STAGE(PG8_SB(0, 0), cB, voffB); PG8_STAGE(PG8_SA(0, 0), cA, voffA); PG8_STAGE(PG8_SB(0, 1), cB + hstep, voffB); PG8_STAGE(PG8_SA(0, 1), cA + hstep, voffA);
        if (wr == 1) PG8_BAR;
        PG8_WAIT_V(4); PG8_BAR;
        PG8_STAGE(PG8_SB(1, 0), cB + kstep, voffB); PG8_STAGE(PG8_SA(1, 0), cA + kstep, voffA); PG8_STAGE(PG8_SB(1, 1), cB + hstep + kstep, voffB);
        PG8_WAIT_V(6); PG8_BAR;
    }
    for (;;) {
        const bool has_next = S.next(ui + 1, nxt);
        const char* nA = has_next ? (const char*)g.A + (size_t)nxt.pm * tstep : cA; const char* nB = has_next ? (const char*)g.Bt + (size_t)nxt.pn * tstep : cB;
        for (int t = 0; t < nt; t += 2) {
            const bool last = (t == nt - 2);
            const char* a1 = cA + (size_t)(t + 1) * kstep;
            const char* a2 = last ? nA : cA + (size_t)(t + 2) * kstep; const char* b2 = last ? nB : cB + (size_t)(t + 2) * kstep;
            const char* a3 = a2 + kstep; const char* b3 = b2 + kstep;
            if (last && has_next) S.a_ready(nxt);
            if constexpr (SP2) {
            PG8_LDB(B0, 0, 0); PG8_LDB(B1, 0, 1); PG8_SCHED; PG8_LDA(At, 0, 0); PG8_STAGE(PG8_SA(1, 1), a1 + hstep, voffA);
            PG8_WAIT_V(8); PG8_WAIT_L(0); PG8_BAR; PG8_MMA(0, 0, At, B0); PG8_MMA(0, 1, At, B1); PG8_BAR; PG8_SCHED;
            PG8_LDA(At, 0, 1); PG8_STAGE(PG8_SB(0, 0), b2, voffB); PG8_STAGE(PG8_SB(0, 1), b2 + hstep, voffB); PG8_STAGE(PG8_SA(0, 0), a2, voffA);
            PG8_WAIT_V(8); PG8_WAIT_L(0); PG8_BAR; PG8_MMA(1, 0, At, B0); PG8_MMA(1, 1, At, B1); PG8_BAR; PG8_SCHED;
            PG8_LDB(B0, 1, 0); PG8_LDB(B1, 1, 1); PG8_SCHED; PG8_LDA(At, 1, 0); PG8_STAGE(PG8_SA(0, 1), a2 + hstep, voffA);
            PG8_WAIT_V(8); PG8_WAIT_L(0); PG8_BAR; PG8_MMA(0, 0, At, B0); PG8_MMA(0, 1, At, B1); PG8_BAR; PG8_SCHED;
            PG8_LDA(At, 1, 1); PG8_STAGE(PG8_SB(1, 0), b3, voffB); PG8_STAGE(PG8_SB(1, 1), b3 + hstep, voffB); PG8_STAGE(PG8_SA(1, 0), a3, voffA);
            PG8_WAIT_V(8); PG8_WAIT_L(0); PG8_BAR; PG8_MMA(1, 0, At, B0); PG8_MMA(1, 1, At, B1); PG8_BAR; PG8_SCHED;
            } else {
            PG8_LDB(B0, 0, 0); PG8_SCHED; PG8_LDA(At, 0, 0); PG8_STAGE(PG8_SA(1, 1), a1 + hstep, voffA);
            PG8_WAIT_L(8); PG8_BAR; PG8_WAIT_L(0); PG8_MMA(0, 0, At, B0); PG8_BAR; PG8_SCHED;
            PG8_LDB(B1, 0, 1); PG8_STAGE(PG8_SB(0, 0), b2, voffB);
            PG8_BAR; PG8_WAIT_L(0); PG8_MMA(0, 1, At, B1); PG8_BAR;
            PG8_LDA(At, 0, 1); PG8_STAGE(PG8_SA(0, 0), a2, voffA);
            PG8_BAR; PG8_WAIT_L(0); PG8_MMA(1, 0, At, B0); PG8_BAR; PG8_SCHED;
            PG8_STAGE(PG8_SB(0, 1), b2 + hstep, voffB);
            PG8_WAIT_V(6); PG8_BAR; PG8_MMA(1, 1, At, B1); PG8_BAR;
            PG8_LDB(B0, 1, 0); PG8_SCHED; PG8_LDA(At, 1, 0); PG8_STAGE(PG8_SA(0, 1), a2 + hstep, voffA);
            PG8_WAIT_L(8); PG8_BAR; PG8_WAIT_L(0); PG8_MMA(0, 0, At, B0); PG8_BAR; PG8_SCHED;
            PG8_LDB(B1, 1, 1); PG8_STAGE(PG8_SB(1, 0), b3, voffB);
            PG8_BAR; PG8_WAIT_L(0); PG8_MMA(0, 1, At, B1); PG8_BAR;
            PG8_LDA(At, 1, 1); PG8_STAGE(PG8_SA(1, 0), a3, voffA);
            PG8_BAR; PG8_WAIT_L(0); PG8_MMA(1, 0, At, B0); PG8_BAR; PG8_SCHED;
            PG8_STAGE(PG8_SB(1, 1), b3 + hstep, voffB);
            PG8_WAIT_V(6); PG8_BAR; PG8_MMA(1, 1, At, B1); PG8_BAR;
            }
        }
        if constexpr (ALIGN_EPI) { if (wr == 0) PG8_BAR; }
        if constexpr (!Epi::AFTER_DRAIN) { E(acc, cur, wr, wc, fr, fq); S.done(cur); }
        if (!has_next) break;
        if (E.zero_after(cur)) {
#pragma unroll
        for (int a = 0; a < 2; ++a)
#pragma unroll
            for (int b = 0; b < 2; ++b)
#pragma unroll
                for (int m = 0; m < 4; ++m)
#pragma unroll
                    for (int n = 0; n < 2; ++n) acc[a][b][m][n] = (f32x4){0.f, 0.f, 0.f, 0.f};
        }
        cur = nxt; cA = nA; cB = nB; ++ui;
        if constexpr (ALIGN_EPI) { if (wr == 1) PG8_BAR; }
    }
    PG8_WAIT_V(0);
    if constexpr (!ALIGN_EPI) { if (wr == 0) PG8_BAR; }
    PG8_BAR;
    if constexpr (Epi::AFTER_DRAIN) { E.fused(acc, cur, wr, wc, fr, fq, lds, wid, lane); S.done(cur); }
#undef PG8_SA
#undef PG8_SB
#undef PG8_STAGE
#undef PG8_LDA
#undef PG8_LDB
#undef PG8_MMA
#undef PG8_WAIT_V
#undef PG8_WAIT_L
#undef PG8_BAR
#undef PG8_SCHED
}
}

namespace att {
typedef unsigned short bf16;
constexpr int D = 128, NW = 8, QBLK = 32, KVBLK = 64;
constexpr float SCALE = 0.088388347648318440f;
constexpr float THR = 8.f;
constexpr int SHM_V = KVBLK * D * 2, SHM_K = KVBLK * D * 2;
constexpr int OFF_WS = 2 * SHM_V + 2 * SHM_K, OFF_TBL = OFF_WS + NW * 64 * 4, OFF_Q = OFF_TBL + 1280, LDS_BYTES = OFF_Q + 64;
constexpr int TBL_N = 259, TBL_PITCH = 260;
using bf16x8 = __attribute__((ext_vector_type(8))) short;
using s16x4  = __attribute__((ext_vector_type(4))) short;
using f32x16 = __attribute__((ext_vector_type(16))) float;
using u32x4  = __attribute__((ext_vector_type(4))) unsigned;
#define KSWZ(row, colB) ((row) * 256 + ((colB) ^ (((row) & 7) << 4)))
#define SBAR() __builtin_amdgcn_sched_barrier(0)
__device__ __forceinline__ int crow(int r, int hi) { return (r & 3) + 8 * (r >> 2) + 4 * hi; }
__device__ __forceinline__ unsigned cvtpk(float lo, float hi) { unsigned r; asm volatile("v_cvt_pk_bf16_f32 %0, %1, %2" : "=v"(r) : "v"(lo), "v"(hi)); return r; }

__device__ __forceinline__ void partialSM(f32x16& p0, f32x16& p1, float& m_reg, float& mn, float& alpha) {
  constexpr float C = SCALE * 1.4426950408889634f;
  float pmax = p0[0];
#pragma unroll
  for (int r = 1; r < 16; ++r) pmax = fmaxf(pmax, p0[r]);
#pragma unroll
  for (int r = 0; r < 16; ++r) pmax = fmaxf(pmax, p1[r]);
  { auto rr = __builtin_amdgcn_permlane32_swap(__float_as_uint(pmax), __float_as_uint(pmax), false, false);
    pmax = fmaxf(__uint_as_float(rr[0]), __uint_as_float(rr[1])); }
  if (__builtin_expect(__all(pmax - m_reg <= THR / SCALE), 1)) { mn = m_reg; alpha = 1.f; }
  else { mn = fmaxf(m_reg, pmax); alpha = __builtin_amdgcn_exp2f((m_reg - mn) * C); m_reg = mn; }
  float mnC = -mn * C;
#pragma unroll
  for (int r = 0; r < 16; ++r) p0[r] = fmaf(p0[r], C, mnC);
#pragma unroll
  for (int r = 0; r < 16; ++r) p1[r] = fmaf(p1[r], C, mnC);
#pragma unroll
  for (int r = 0; r < 16; ++r) p0[r] = __builtin_amdgcn_exp2f(p0[r]);
}
__device__ __forceinline__ void finishSM(f32x16& p0, f32x16& p1, float alpha, float& l_reg, bf16x8& pa0, bf16x8& pa1, bf16x8& pa2, bf16x8& pa3) {
#pragma unroll
  for (int r = 0; r < 16; ++r) p1[r] = __builtin_amdgcn_exp2f(p1[r]);
  float ps = 0;
#pragma unroll
  for (int r = 0; r < 16; ++r) ps += p0[r];
#pragma unroll
  for (int r = 0; r < 16; ++r) ps += p1[r];
  { auto rr = __builtin_amdgcn_permlane32_swap(__float_as_uint(ps), __float_as_uint(ps), false, false);
    ps = __uint_as_float(rr[0]) + __uint_as_float(rr[1]); }
  l_reg = l_reg * alpha + ps;
#define PK4(P, BASE, OUT) do { unsigned a0 = cvtpk(P[BASE + 0], P[BASE + 1]), a1 = cvtpk(P[BASE + 2], P[BASE + 3]);   \
    unsigned b0 = cvtpk(P[BASE + 4], P[BASE + 5]), b1 = cvtpk(P[BASE + 6], P[BASE + 7]);                              \
    auto r0 = __builtin_amdgcn_permlane32_swap(a0, b0, false, false); auto r1 = __builtin_amdgcn_permlane32_swap(a1, b1, false, false); \
    u32x4 w = {r0[0], r1[0], r0[1], r1[1]}; OUT = *reinterpret_cast<bf16x8*>(&w); } while (0)
  PK4(p0, 0, pa0); PK4(p0, 8, pa1); PK4(p1, 0, pa2); PK4(p1, 8, pa3);
#undef PK4
}
__device__ __forceinline__ void qkt(f32x16& p0, f32x16& p1, const bf16* Ks, const bf16x8* qr, int r32, int hi, float cinit) {
#pragma unroll
  for (int r = 0; r < 16; ++r) { p0[r] = cinit; p1[r] = cinit; }
#pragma unroll
  for (int d0 = 0; d0 < 8; ++d0) { int cb = (d0 * 16 + hi * 8) * 2;
    bf16x8 b0 = *reinterpret_cast<const bf16x8*>((const char*)Ks + KSWZ(r32, cb));
    bf16x8 b1 = *reinterpret_cast<const bf16x8*>((const char*)Ks + KSWZ(32 + r32, cb));
    p0 = __builtin_amdgcn_mfma_f32_32x32x16_bf16(b0, qr[d0], p0, 0, 0, 0);
    p1 = __builtin_amdgcn_mfma_f32_32x32x16_bf16(b1, qr[d0], p1, 0, 0, 0); }
}
__device__ __forceinline__ void add_bias(f32x16& p0, f32x16& p1, const float* tbl, int base) {
#pragma unroll
  for (int r = 0; r < 16; ++r) { const int c = (r & 3) + 8 * (r >> 2);
    int i0 = base + c, i1 = base + 32 + c; i0 = min(max(i0, 0), TBL_N - 1); i1 = min(max(i1, 0), TBL_N - 1);
    p0[r] += tbl[i0]; p1[r] += tbl[i1]; }
}
__device__ __forceinline__ int v_st(int k, int c) { const int kk = (k & ~0xC) | ((k & 4) << 1) | ((k & 8) >> 1); return ((kk >> 3) * 4 + (c >> 5)) * 512 + ((kk & 7) * 32 + (c & 31)) * 2; }
__device__ __forceinline__ int v_rd_base(int lane) { return ((lane & 3) << 3) | (((lane >> 2) & 3) << 6) | (((lane >> 4) & 1) << 5) | (((lane >> 5) & 1) << 8); }
constexpr int v_rd_off(int d0, int ks, int half) { return d0 * 512 + ks * 4096 + half * 2048; }
template <int OFF> __device__ __forceinline__ s16x4 tr_read(int vb) {
  s16x4 r; asm volatile("ds_read_b64_tr_b16 %0, %1 offset:%2" : "=&v"(r) : "v"(vb), "i"(OFF) : "memory"); return r;
}
template <int D0> __device__ __forceinline__ void pv_one(f32x16& od, int vb, bf16x8 pa0, bf16x8 pa1, bf16x8 pa2, bf16x8 pa3) {
  const s16x4 l0 = tr_read<v_rd_off(D0, 0, 0)>(vb), h0 = tr_read<v_rd_off(D0, 0, 1)>(vb), l1 = tr_read<v_rd_off(D0, 1, 0)>(vb), h1 = tr_read<v_rd_off(D0, 1, 1)>(vb);
  const s16x4 l2 = tr_read<v_rd_off(D0, 2, 0)>(vb), h2 = tr_read<v_rd_off(D0, 2, 1)>(vb), l3 = tr_read<v_rd_off(D0, 3, 0)>(vb), h3 = tr_read<v_rd_off(D0, 3, 1)>(vb);
  asm volatile("s_waitcnt lgkmcnt(0)" ::: "memory"); SBAR();
#define PK(L, H) (bf16x8){L[0], L[1], L[2], L[3], H[0], H[1], H[2], H[3]}
  od = __builtin_amdgcn_mfma_f32_32x32x16_bf16(pa0, PK(l0, h0), od, 0, 0, 0);
  od = __builtin_amdgcn_mfma_f32_32x32x16_bf16(pa1, PK(l1, h1), od, 0, 0, 0);
  od = __builtin_amdgcn_mfma_f32_32x32x16_bf16(pa2, PK(l2, h2), od, 0, 0, 0);
  od = __builtin_amdgcn_mfma_f32_32x32x16_bf16(pa3, PK(l3, h3), od, 0, 0, 0);
#undef PK
}
__device__ __forceinline__ void pv_d0(f32x16* o, int vb, bf16x8 pa0, bf16x8 pa1, bf16x8 pa2, bf16x8 pa3) {
  pv_one<0>(o[0], vb, pa0, pa1, pa2, pa3); pv_one<1>(o[1], vb, pa0, pa1, pa2, pa3); pv_one<2>(o[2], vb, pa0, pa1, pa2, pa3); pv_one<3>(o[3], vb, pa0, pa1, pa2, pa3);
}

struct UnitP {
  const bf16* Q; const bf16* K; const bf16* V;
  void* O;
  int nt;
  int rel0;
  int mode;
  const float* tbl;
  float sink_l2;
  int obf;
};

template <int LDQ, int LDK, int LDO, bool BIAS>
__device__ __forceinline__ void attn_unit(const UnitP& P, char* lds) {
  int tid = threadIdx.x; asm volatile("" : "+v"(tid)); const int wid = __builtin_amdgcn_readfirstlane(tid >> 6), lane = tid & 63, r32 = lane & 31, hi = lane >> 5;
  bf16* V_lds = (bf16*)lds; bf16* K_lds = (bf16*)(lds + 2 * SHM_V);
  float* ws = (float*)(lds + OFF_WS) + wid * 64; float* li_l = ws; float* al_l = ws + 32;
  float* tblL = (float*)(lds + OFF_TBL);
  const bf16* __restrict__ Kh = P.K; const bf16* __restrict__ Vh = P.V;
  float m_reg = -1e30f, l_reg = 0; f32x16 o[4] = {}; bf16x8 qr[8];
  const bf16* Qw = P.Q + (long)(wid * QBLK + r32) * LDQ + hi * 8;
#pragma unroll
  for (int d0 = 0; d0 < 8; ++d0) qr[d0] = *reinterpret_cast<const bf16x8*>(Qw + d0 * 16);
  float cL = 0.f, cR = 0.f;
  if (BIAS) { if (P.mode != 0) { if (tid < TBL_N) tblL[tid] = P.tbl[tid]; cL = P.tbl[0]; cR = P.tbl[TBL_N - 1]; } }
  const int relw = P.rel0 - wid * QBLK;
  const int lbase = relw - r32 + 129 + 4 * hi;
  const int sr = tid >> 4, sc = (tid & 15) * 8, vst0 = v_st(sr, sc), vst1 = v_st(32 + sr, sc);
  const int vb0 = (int)(uintptr_t)V_lds + v_rd_base(lane);
  struct { bf16x8 vs0, vs1, ks0, ks1; } sr_[2];
#define SLOAD(i, k0) do { sr_[i].vs0 = *reinterpret_cast<const bf16x8*>(&Vh[(long)((k0) + sr) * LDK + sc]); sr_[i].vs1 = *reinterpret_cast<const bf16x8*>(&Vh[(long)((k0) + 32 + sr) * LDK + sc]); \
    sr_[i].ks0 = *reinterpret_cast<const bf16x8*>(&Kh[(long)((k0) + sr) * LDK + sc]); sr_[i].ks1 = *reinterpret_cast<const bf16x8*>(&Kh[(long)((k0) + 32 + sr) * LDK + sc]); } while (0)
#define SWRITE(b, i) do { *(bf16x8*)((char*)V_lds + (b) * SHM_V + vst0) = sr_[i].vs0;          \
    *(bf16x8*)((char*)V_lds + (b) * SHM_V + vst1) = sr_[i].vs1; int kc = sc * 2;               \
    *(bf16x8*)((char*)K_lds + (b) * SHM_K + KSWZ(sr, kc)) = sr_[i].ks0;                       \
    *(bf16x8*)((char*)K_lds + (b) * SHM_K + KSWZ(32 + sr, kc)) = sr_[i].ks1; } while (0)
#define SWAIT() asm volatile("s_waitcnt vmcnt(4)" ::: "memory")
#define RESC(a) do { if (__any((a) < 1.f)) { if (hi == 0) al_l[r32] = (a); asm volatile("s_waitcnt lgkmcnt(0)" ::: "memory"); \
    _Pragma("unroll") for (int d = 0; d < 4; ++d) _Pragma("unroll") for (int r = 0; r < 16; ++r) o[d][r] *= al_l[crow(r, hi)]; } } while (0)
#define CINIT(j, cin, slow) do { cin = 0.f; slow = false; if (BIAS) { const int dmin = relw + 64 * (j) - 31, dmax = relw + 64 * (j) + 63; \
    if (P.mode == 1 && dmax <= -91) cin = cL; else if (P.mode == 1 && dmin >= 91) cin = cR; else slow = (P.mode != 0); } } while (0)
#define TBIAS(j, slow, p0, p1) do { if (BIAS) { if (slow) add_bias(p0, p1, tblL, lbase + 64 * (j)); } } while (0)
  f32x16 pA0, pA1, pB0, pB1; float mnA, mnB, alA, alB; bf16x8 pa0, pa1, pa2, pa3; const int NT = P.nt;
  float cinA, cinB; bool slA, slB;
  constexpr int SE = 0, SO = 1;
  SLOAD(SE, 0); asm volatile("s_waitcnt vmcnt(0)" ::: "memory"); SWRITE(0, SE); __syncthreads();
  CINIT(0, cinA, slA);
  qkt(pA0, pA1, K_lds, qr, r32, hi, cinA); TBIAS(0, slA, pA0, pA1); partialSM(pA0, pA1, m_reg, mnA, alA);
  SLOAD(SO, KVBLK); if (2 < NT) SLOAD(SE, 2 * KVBLK);
  SWAIT(); SWRITE(1, SO); __syncthreads();
  for (int j = 1; j + 1 < NT; j += 2) {
    CINIT(j, cinB, slB);
    SBAR(); qkt(pB0, pB1, (bf16*)((char*)K_lds + SHM_K), qr, r32, hi, cinB);
    finishSM(pA0, pA1, alA, l_reg, pa0, pa1, pa2, pa3); SBAR();
    SLOAD(SO, (j + 2) * KVBLK); SBAR();
    pv_d0(o, vb0, pa0, pa1, pa2, pa3); TBIAS(j, slB, pB0, pB1); partialSM(pB0, pB1, m_reg, mnB, alB);
    __syncthreads(); SWAIT(); SWRITE(0, SE);
    RESC(alB); __syncthreads();
    CINIT(j + 1, cinA, slA);
    SBAR(); qkt(pA0, pA1, K_lds, qr, r32, hi, cinA);
    finishSM(pB0, pB1, alB, l_reg, pa0, pa1, pa2, pa3); SBAR();
    if (j + 3 < NT) SLOAD(SE, (j + 3) * KVBLK); SBAR();
    pv_d0(o, vb0 + (int)SHM_V, pa0, pa1, pa2, pa3); TBIAS(j + 1, slA, pA0, pA1); partialSM(pA0, pA1, m_reg, mnA, alA);
    __syncthreads(); SWAIT(); SWRITE(1, SO);
    RESC(alA); __syncthreads();
  }
  CINIT(NT - 1, cinB, slB);
  SBAR(); qkt(pB0, pB1, (bf16*)((char*)K_lds + SHM_K), qr, r32, hi, cinB);
  finishSM(pA0, pA1, alA, l_reg, pa0, pa1, pa2, pa3); SBAR();
  pv_d0(o, vb0, pa0, pa1, pa2, pa3); TBIAS(NT - 1, slB, pB0, pB1); partialSM(pB0, pB1, m_reg, mnB, alB);
  __syncthreads(); RESC(alB);
  finishSM(pB0, pB1, alB, l_reg, pa0, pa1, pa2, pa3); SBAR();
  pv_d0(o, vb0 + (int)SHM_V, pa0, pa1, pa2, pa3);
  if (BIAS) l_reg += __builtin_amdgcn_exp2f(P.sink_l2 - m_reg * (SCALE * 1.4426950408889634f));
  if (hi == 0) li_l[r32] = l_reg; asm volatile("s_waitcnt lgkmcnt(0)" ::: "memory");
  float rli[16];
#pragma unroll
  for (int r = 0; r < 16; ++r) rli[r] = __builtin_amdgcn_rcpf(li_l[crow(r, hi)]);
  if (P.obf) { bf16* Ow = (bf16*)P.O + (long)(wid * QBLK) * LDO;
#pragma unroll
    for (int r = 0; r < 16; ++r) { const int orow = crow(r, hi);
#pragma unroll
      for (int d0 = 0; d0 < 4; ++d0) Ow[(long)orow * LDO + d0 * 32 + r32] = (bf16)(cvtpk(o[d0][r] * rli[r], 0.f) & 0xffffu); }
  } else { float* Ow = (float*)P.O + (long)(wid * QBLK) * LDO;
#pragma unroll
    for (int r = 0; r < 16; ++r) { const int orow = crow(r, hi);
#pragma unroll
      for (int d0 = 0; d0 < 4; ++d0) Ow[(long)orow * LDO + d0 * 32 + r32] = o[d0][r] * rli[r]; }
  }
  __syncthreads();
#undef SLOAD
#undef SWRITE
#undef SWAIT
#undef RESC
#undef CINIT
#undef TBIAS
}
#undef KSWZ
#undef SBAR
}


constexpr int NWAVES = 8;
constexpr int DM = 2048, DFF = 5632, DEPTH = 4, INW = 12288, MEMI = 512;
constexpr int M = 16384;
constexpr int MEMROWS = 1536;
constexpr float ALPHA = 1.6817928305074290f;
constexpr float LN_EPS = 1e-5f, RMS_EPS = 1e-6f;
constexpr int C_QA = 0, C_KA = 1024, C_VA = 2048, C_QB = 3072, C_KB = 4096, C_VB = 4352, C_QC = 4608, C_KC = 5632, C_VC = 5888, C_GATE = 6144;

constexpr size_t MiB = 1u << 20;
constexpr size_t WS_CTL = 0, CTL_ZERO_BYTES = 1 * MiB;
constexpr size_t WS_BT = 1 * MiB;
constexpr size_t WS_COS = 2 * MiB, WS_SIN = 3 * MiB;
constexpr size_t WS_WGU = 4 * MiB;
constexpr size_t SZ_WGU = (size_t)11264 * 2048 * 2;
constexpr size_t WS_WD = WS_WGU + 8 * SZ_WGU;
constexpr size_t SZ_WD = (size_t)2048 * 5632 * 2;
constexpr size_t WS_WIN = WS_WD + 8 * SZ_WD;
constexpr size_t SZ_WIN = (size_t)12288 * 2048 * 2;
constexpr size_t WS_WBR = WS_WIN + 4 * SZ_WIN;
constexpr size_t SZ_WBR = (size_t)3 * 2048 * 1024 * 2;
constexpr size_t WS_WOUT = WS_WBR + 4 * SZ_WBR;
constexpr size_t SZ_WOUT = (size_t)2048 * 2048 * 2;
constexpr size_t WS_WMQ = WS_WOUT + 4 * SZ_WOUT;
constexpr size_t SZ_WMQ = (size_t)512 * 2048 * 2;
constexpr size_t WS_WMKV = WS_WMQ + 4 * SZ_WMQ;
constexpr size_t SZ_WMKV = (size_t)1024 * 2048 * 2;
constexpr size_t WS_WMO = WS_WMKV + 4 * SZ_WMKV;
constexpr size_t SZ_WMO = (size_t)2048 * 512 * 2;
constexpr size_t WS_XB = WS_WMO + 4 * SZ_WMO;
constexpr size_t WS_Z = WS_XB + (size_t)M * DM * 2;
constexpr size_t WS_H = WS_Z + (size_t)M * DM * 4;
constexpr size_t WS_P = WS_H + (size_t)M * DFF * 2;
constexpr size_t WS_O12 = WS_P + (size_t)M * INW * 2;
constexpr size_t WS_YS = WS_O12 + (size_t)2 * M * 1024 * 4;
constexpr size_t WS_MG = WS_YS + (size_t)3 * M * 1024 * 2;
constexpr size_t WS_MQ = WS_MG + (size_t)M * DM * 2;
constexpr size_t WS_MO = WS_MQ + (size_t)M * MEMI * 2;
constexpr size_t WS_MKV = WS_MO + (size_t)M * MEMI * 2;
constexpr size_t WS_MEMB = WS_MKV + (size_t)MEMROWS * 4096 * 2;
constexpr size_t WS_END = WS_MEMB + (size_t)MEMROWS * DM * 2;
constexpr int CW_Q = 1024;
constexpr int CW_BAR = 4096;
constexpr int MAX_BAR_REGIONS = 70;
constexpr int RING_BYTES = 131072, LDSCTL_OFF = RING_BYTES, MISC_OFF = LDSCTL_OFF + 320, LDS_BYTES = 147456;

#define GAS __attribute__((address_space(1)))
#define LAS __attribute__((address_space(3)))
typedef unsigned short bf16;
typedef unsigned v4u __attribute__((ext_vector_type(4)));
typedef unsigned v2u __attribute__((ext_vector_type(2)));
typedef float f32x4 __attribute__((ext_vector_type(4)));
#define LDS_WAIT() asm volatile("s_waitcnt lgkmcnt(0)" ::: "memory")
#define VM_WAIT() asm volatile("s_waitcnt vmcnt(0)" ::: "memory")
__device__ __forceinline__ unsigned pk2(float lo, float hi) { unsigned r; asm volatile("v_cvt_pk_bf16_f32 %0, %1, %2" : "=v"(r) : "v"(lo), "v"(hi)); return r; }
__device__ __forceinline__ float bf2f(unsigned short h) { return __uint_as_float(((unsigned)h) << 16); }

#define XB_TMO      128
#define XB_XCNT(j)  (256  + 64 * (j))
#define XB_XSUB(j)  (1280 + 64 * (j))
#define XB_XGEN(j)  (2304 + 64 * (j))
#define XB_TOP      3328
#define XB_TOPGEN   3392
#define XCD_BAR_WORDS 3456
#define XB_SPIN_CAP (1u << 18)

__device__ __forceinline__ unsigned xb_ld(unsigned* p)              { return __hip_atomic_load(p, __ATOMIC_RELAXED, __HIP_MEMORY_SCOPE_AGENT); }
__device__ __forceinline__ unsigned xb_add(unsigned* p, unsigned v) { return __hip_atomic_fetch_add(p, v, __ATOMIC_RELAXED, __HIP_MEMORY_SCOPE_AGENT); }
__device__ __forceinline__ unsigned xb_xcc_id() { return (unsigned)__builtin_amdgcn_s_getreg((3 << 11) | 20) & 0xFu; }
#define XB_SPIN(cond, bar) do { unsigned _sp = 0; while (cond) { __builtin_amdgcn_s_sleep(1); \
    if ((++_sp & 255u) == 0u) { if (xb_ld(&(bar)[XB_TMO])) break; if (_sp > XB_SPIN_CAP) { atomicAdd(&(bar)[XB_TMO], 1u); break; } } } } while (0)

struct XcdBarrier {
    unsigned* bar; unsigned x;
    volatile LAS unsigned* st;
};

__device__ __forceinline__ XcdBarrier xcd_barrier_post(unsigned* bar, volatile LAS unsigned* st) {
    XcdBarrier b; b.bar = bar; b.x = xb_xcc_id(); b.st = st;
    if (threadIdx.x == 0) (void)xb_add(&bar[XB_XCNT(b.x)], 1u);
    return b;
}
__device__ __forceinline__ void xcd_barrier_complete(unsigned* bar, unsigned x, unsigned& nloc, unsigned& nx) {
    const unsigned G = gridDim.x * gridDim.y * gridDim.z;
    unsigned sum, cnt, mine, sp = 0u;
    for (;;) {
        sum = 0u; cnt = 0u; mine = 0u;
#pragma unroll
        for (unsigned j = 0; j < 16; ++j) { const unsigned c = xb_ld(&bar[XB_XCNT(j)]); sum += c; cnt += (c > 0u) ? 1u : 0u; mine = (j == x) ? c : mine; }
        if (sum == G) break;
        __builtin_amdgcn_s_sleep(1);
        if ((++sp & 255u) == 0u) { if (xb_ld(&bar[XB_TMO])) break; if (sp > XB_SPIN_CAP) { atomicAdd(&bar[XB_TMO], 1u); break; } }
    }
    nloc = mine > 0u ? mine : 1u; nx = cnt > 0u ? cnt : 1u;
}

__device__ __forceinline__ void xcd_barrier(const XcdBarrier& b) {
    unsigned z_ = 0u; asm volatile("" : "+s"(z_));
    asm volatile("s_waitcnt vmcnt(0)" ::: "memory");
    __syncthreads();
    if (threadIdx.x == 0) {
        unsigned* bar = b.bar + z_; const unsigned bx = b.x + z_;
        __builtin_amdgcn_s_waitcnt(0);
        unsigned nloc = b.st[0], nx = b.st[1];
        if (nloc == 0u) { xcd_barrier_complete(bar, bx, nloc, nx); b.st[0] = nloc; b.st[1] = nx; }
        const unsigned old = xb_add(&bar[XB_XSUB(bx)], 1u);
        const unsigned gen = old / nloc;
        if (old + 1u == (gen + 1u) * nloc) {
            __builtin_amdgcn_fence(__ATOMIC_RELEASE, "agent");
            asm volatile("s_waitcnt vmcnt(0)" ::: "memory");
            const unsigned og = xb_add(&bar[XB_TOP], 1u);
            const unsigned tg = og / nx;
            if (og + 1u == (tg + 1u) * nx) xb_add(&bar[XB_TOPGEN], 1u);
            else XB_SPIN(xb_ld(&bar[XB_TOPGEN]) == tg, bar);
            __builtin_amdgcn_fence(__ATOMIC_ACQUIRE, "agent");
            xb_add(&bar[XB_XGEN(bx)], 1u);
            asm volatile("s_waitcnt vmcnt(0)" ::: "memory");
        } else {
            XB_SPIN(xb_ld(&bar[XB_XGEN(bx)]) == gen, bar);
            __builtin_amdgcn_fence(__ATOMIC_ACQUIRE, "agent");
            asm volatile("s_waitcnt vmcnt(0)" ::: "memory");
        }
    }
    __syncthreads();
}

__device__ __forceinline__ float wave_sum(float v, int lane) {
#pragma unroll
    for (int o = 1; o < 64; o <<= 1) v += __int_as_float(__builtin_amdgcn_ds_bpermute((lane ^ o) << 2, __float_as_int(v)));
    return v;
}
__device__ __forceinline__ void transpose_item(const float* W, int K, int N, bf16* WT, LAS float* scr, int k0, int n0, int drow0, int lane) {
#pragma unroll 8
    for (int i = 0; i < 32; ++i) { const int kk = 2 * i + (lane >> 5); scr[kk * 33 + (lane & 31)] = W[(size_t)(k0 + kk) * N + n0 + (lane & 31)]; }
    LDS_WAIT(); asm volatile("" ::: "memory");
    const int c = lane & 7;
#pragma unroll
    for (int j = 0; j < 4; ++j) { const int n = (lane >> 3) + 8 * j; const LAS float* s = scr + (8 * c) * 33 + n;
        v4u o; o.x = pk2(s[0 * 33], s[1 * 33]); o.y = pk2(s[2 * 33], s[3 * 33]); o.z = pk2(s[4 * 33], s[5 * 33]); o.w = pk2(s[6 * 33], s[7 * 33]);
        *(GAS v4u*)(WT + (size_t)(drow0 + n) * K + k0 + 8 * c) = o; }
    LDS_WAIT(); asm volatile("" ::: "memory");
}
template <bool GU>
__device__ __forceinline__ void transpose_matrix(const float* W, int K, int N, bf16* WT, LAS float* scr, int gw, int NGW, int lane) {
    const int nblk = N / 32, items = (K / 64) * nblk;
    for (int it = gw; it < items; it += NGW) { const int kb = it / nblk, nb = it - kb * nblk, n0 = 32 * nb;
        int drow0 = n0;
        if (GU) { const int half = N / 2; const int nn = n0 < half ? n0 : n0 - half; drow0 = (nn >> 7) * 256 + (nn & 127) + (n0 < half ? 0 : 128); }
        transpose_item(W, K, N, WT, scr, 64 * kb, n0, drow0, lane); }
}
__device__ __forceinline__ void cvt_rows(const float* src, bf16* dstb, float* dstf, int rows, int gw, int NGW, int lane) {
    for (int r = gw; r < rows; r += NGW) { const GAS f32x4* s = (const GAS f32x4*)(src + (size_t)r * DM) + lane;
#pragma unroll
        for (int j = 0; j < 8; ++j) { const f32x4 v = s[64 * j];
            if (dstf) ((GAS f32x4*)(dstf + (size_t)r * DM) + lane)[64 * j] = v;
            v2u w; w.x = pk2(v.x, v.y); w.y = pk2(v.z, v.w); ((GAS v2u*)(dstb + (size_t)r * DM) + lane)[64 * j] = w; } }
}
__device__ __forceinline__ int t5_bucket(int rel) {
    const int n = rel < 0 ? -rel : rel; int b;
    if (n < 8) b = n; else if (n < 12) b = 8; else if (n < 16) b = 9; else if (n < 23) b = 10; else if (n < 32) b = 11; else if (n < 46) b = 12; else if (n < 64) b = 13; else if (n < 91) b = 14; else b = 15;
    return b + (rel > 0 ? 16 : 0);
}
__device__ __forceinline__ void ln_phase(const float* Z, float* X, bf16* XB, const float* g, const float* b, int gw, int NGW, int lane) {
    f32x4 gv[8], bv[8];
#pragma unroll
    for (int j = 0; j < 8; ++j) { gv[j] = ((const GAS f32x4*)g + lane)[64 * j]; bv[j] = ((const GAS f32x4*)b + lane)[64 * j]; }
    for (int r = gw; r < M; r += NGW) { const GAS f32x4* zr = (const GAS f32x4*)(Z + (size_t)r * DM) + lane;
        f32x4 v[8]; float s = 0.f;
#pragma unroll
        for (int j = 0; j < 8; ++j) { v[j] = zr[64 * j]; s += (v[j].x + v[j].y) + (v[j].z + v[j].w); }
        const float mean = wave_sum(s, lane) * (1.f / DM); float s2 = 0.f;
#pragma unroll
        for (int j = 0; j < 8; ++j) { v[j] = v[j] - mean; s2 += (v[j].x * v[j].x + v[j].y * v[j].y) + (v[j].z * v[j].z + v[j].w * v[j].w); }
        const float rstd = 1.f / sqrtf(wave_sum(s2, lane) * (1.f / DM) + LN_EPS);
#pragma unroll
        for (int j = 0; j < 8; ++j) { const f32x4 y = v[j] * rstd * gv[j] + bv[j];
            ((GAS f32x4*)(X + (size_t)r * DM) + lane)[64 * j] = y;
            v2u w; w.x = pk2(y.x, y.y); w.y = pk2(y.z, y.w); ((GAS v2u*)(XB + (size_t)r * DM) + lane)[64 * j] = w; } }
}
__device__ __forceinline__ void rope_phase(bf16* P, const float* qg, const float* kg, const float* cosT, const float* sinT, int gw, int NGW, int lane) {
    const GAS float* qgg = (const GAS float*)qg; const GAS float* kgg = (const GAS float*)kg; const float qg1 = qgg[lane], qg2 = qgg[lane + 64], kg1 = kgg[lane], kg2 = kgg[lane + 64];
    for (int r = gw; r < M; r += NGW) { const int pos = r < 8192 ? (r & 4095) : (r & 2047);
        const float c = cosT[pos * 64 + lane], s = sinT[pos * 64 + lane];
#pragma unroll
        for (int hh = 0; hh < 10; ++hh) { bf16* p = P + (size_t)r * INW + (hh < 8 ? C_QC + hh * 128 : C_KC + (hh - 8) * 128) + lane;
            float x1 = bf2f(p[0]), x2 = bf2f(p[64]);
            const float ss = wave_sum(x1 * x1 + x2 * x2, lane), rr = 1.f / sqrtf(ss * (1.f / 128.f) + RMS_EPS);
            x1 = x1 * rr * (hh < 8 ? qg1 : kg1); x2 = x2 * rr * (hh < 8 ? qg2 : kg2);
            const float y1 = x1 * c - x2 * s, y2 = x1 * s + x2 * c;
            p[0] = (bf16)(pk2(y1, 0.f) & 0xffffu); p[64] = (bf16)(pk2(y2, 0.f) & 0xffffu); } }
}
__device__ __forceinline__ void diffcomb_phase(const float* O12, bf16* YS0, const float* lamqk, const float* subg, int layer, int gw, int NGW, int lane) {
    float c08 = 0.8f; asm volatile("" : "+v"(c08)); const GAS float* lamg = (const GAS float*)lamqk;
    const float linit = c08 - 0.6f * __expf(-0.3f * (float)layer);
    const float d1 = wave_sum(lamg[lane] * lamg[128 + lane] + lamg[64 + lane] * lamg[192 + lane], lane);
    const float d2 = wave_sum(lamg[256 + lane] * lamg[384 + lane] + lamg[320 + lane] * lamg[448 + lane], lane);
    const float lam = __expf(d1) - __expf(d2) + linit;
    const f32x4 g = ((const GAS f32x4*)subg)[lane];
    for (int it = gw; it < M * 4; it += NGW) { const int r = it >> 2, h = it & 3;
        const f32x4 o1 = ((const GAS f32x4*)(O12 + (size_t)r * 1024 + h * 256))[lane], o2 = ((const GAS f32x4*)(O12 + (size_t)M * 1024 + (size_t)r * 1024 + h * 256))[lane];
        const f32x4 d = o1 - o2 * lam;
        const float ss = wave_sum((d.x * d.x + d.y * d.y) + (d.z * d.z + d.w * d.w), lane);
        const float rr = (1.f - linit) / sqrtf(ss * (1.f / 256.f) + RMS_EPS);
        const f32x4 y = d * rr * g;
        v2u w; w.x = pk2(y.x, y.y); w.y = pk2(y.z, y.w); ((GAS v2u*)(YS0 + (size_t)r * 1024 + h * 256))[lane] = w; }
}


struct Args { const float* in[19]; float* out; unsigned char* ws; int ph_lo, ph_hi, li, pad; };
enum { I_XP = 0, I_XS, I_MP, I_MS, I_RBT, I_WIN, I_WBR, I_WOUT, I_LAMQK, I_SUBG, I_SINK, I_QKG, I_WMQ, I_WMKV, I_WMO, I_WGU, I_WD, I_LNG, I_LNB };

constexpr size_t WS_PT = WS_BT + 16384;
__device__ __forceinline__ int tid_fresh() { int t = threadIdx.x; asm volatile("" : "+v"(t)); return t; }
template <class T> __device__ __forceinline__ T* as_global(T* p) { return (T*)(GAS T*)p; }
#define PHASE_PROLOG() unsigned zo_ = 0u; asm volatile("" : "+s"(zo_)); unsigned char* wsp = ws + zo_; const float* const* IN = (const float* const*)(wsp + WS_PT); \
    const int tid = tid_fresh(), lane = tid & 63, wave = __builtin_amdgcn_readfirstlane(tid >> 6), gw = bid * NWAVES + wave; (void)lane; (void)gw; (void)IN
#define WSP(T, off) ((T*)(wsp + (off)))

__global__ void __launch_bounds__(NWAVES * 64, 2) fwd(Args args) {
    extern __shared__ __attribute__((aligned(16))) unsigned char lds[];
    LAS unsigned char* ldsl = (LAS unsigned char*)lds;
    volatile LAS unsigned* MISC = (volatile LAS unsigned*)(ldsl + MISC_OFF);
    const int G = gridDim.x, bid = blockIdx.x, NGW = G * NWAVES;
    unsigned char* ws = args.ws;
    unsigned* ctl = (unsigned*)(ws + WS_CTL);
    { const int t0 = tid_fresh(); for (int u = t0; u < (LDS_BYTES - LDSCTL_OFF) / 4; u += NWAVES * 64) ((LAS unsigned*)(ldsl + LDSCTL_OFF))[u] = 0u; }
    __syncthreads();
    const int lo = args.ph_lo, hi = args.ph_hi;
    const bool use_bar = (hi - lo) > 1;
    XcdBarrier bar; bar.bar = ctl + CW_BAR + args.li * XCD_BAR_WORDS; bar.x = 0; bar.st = nullptr;
    if (use_bar) bar = xcd_barrier_post(ctl + CW_BAR + args.li * XCD_BAR_WORDS, MISC + 8);
    int ph = 0;
#define PH_ON (ph >= lo && ph < hi)
#define SEAM() do { ++ph; if (ph > lo && ph < hi) xcd_barrier(bar); } while (0)

    if (PH_ON) {
        unsigned char* wsp = ws; const int tid = tid_fresh(), lane = tid & 63, wave = __builtin_amdgcn_readfirstlane(tid >> 6), gw = bid * NWAVES + wave;
        if (bid == 0 && tid == 0) { const float** PT = WSP(const float*, WS_PT);
#pragma unroll
            for (int i = 0; i < 19; ++i) PT[i] = args.in[i];
            PT[19] = args.out; }
        LAS float* scr = (LAS float*)(ldsl + wave * 16384);
        for (int l = 0; l < DEPTH; ++l) {
            transpose_matrix<false>(args.in[I_WIN] + (size_t)l * DM * INW, DM, INW, WSP(bf16, WS_WIN + l * SZ_WIN), scr, gw, NGW, lane);
            for (int n = 0; n < 3; ++n) transpose_matrix<false>(args.in[I_WBR] + (size_t)(l * 3 + n) * 1024 * DM, 1024, DM, WSP(bf16, WS_WBR + l * SZ_WBR) + (size_t)n * DM * 1024, scr, gw, NGW, lane);
            transpose_matrix<false>(args.in[I_WOUT] + (size_t)l * DM * DM, DM, DM, WSP(bf16, WS_WOUT + l * SZ_WOUT), scr, gw, NGW, lane);
            transpose_matrix<false>(args.in[I_WMQ] + (size_t)l * DM * MEMI, DM, MEMI, WSP(bf16, WS_WMQ + l * SZ_WMQ), scr, gw, NGW, lane);
            transpose_matrix<false>(args.in[I_WMKV] + (size_t)l * DM * 1024, DM, 1024, WSP(bf16, WS_WMKV + l * SZ_WMKV), scr, gw, NGW, lane);
            transpose_matrix<false>(args.in[I_WMO] + (size_t)l * MEMI * DM, MEMI, DM, WSP(bf16, WS_WMO + l * SZ_WMO), scr, gw, NGW, lane);
            for (int f = 0; f < 2; ++f) {
                transpose_matrix<true>(args.in[I_WGU] + (size_t)(l * 2 + f) * DM * 2 * DFF, DM, 2 * DFF, WSP(bf16, WS_WGU + (l * 2 + f) * SZ_WGU), scr, gw, NGW, lane);
                transpose_matrix<false>(args.in[I_WD] + (size_t)(l * 2 + f) * DFF * DM, DFF, DM, WSP(bf16, WS_WD + (l * 2 + f) * SZ_WD), scr, gw, NGW, lane);
            }
        }
        cvt_rows(args.in[I_XP], WSP(bf16, WS_XB), args.out, 8192, gw, NGW, lane);
        cvt_rows(args.in[I_XS], WSP(bf16, WS_XB) + (size_t)8192 * DM, args.out + (size_t)8192 * DM, 8192, gw, NGW, lane);
        cvt_rows(args.in[I_MP], WSP(bf16, WS_MEMB), nullptr, 512, gw, NGW, lane);
        cvt_rows(args.in[I_MS], WSP(bf16, WS_MEMB) + (size_t)512 * DM, nullptr, 1024, gw, NGW, lane);
        const int gt = bid * NWAVES * 64 + tid, NGT = G * NWAVES * 64;
        float* BT = WSP(float, WS_BT); float* COS = WSP(float, WS_COS); float* SIN = WSP(float, WS_SIN);
        for (int i = gt; i < 12 * att::TBL_PITCH; i += NGT) { const int hd = i / att::TBL_PITCH, k = i - hd * att::TBL_PITCH; const int rel = k - 129, n = rel < 0 ? -rel : rel;
            float v = 0.f;
            if (k < att::TBL_N) { if (hd >= 4 && n > 128) v = -1e30f / att::SCALE; else v = args.in[I_RBT][t5_bucket(rel) * 12 + hd] * (1.0f / att::SCALE); }
            BT[i] = v; }
        for (int i = gt; i < 4096 * 64; i += NGT) { const int pos = i >> 6, jj = i & 63; const int f = jj & 31;
            const float inv = __builtin_amdgcn_exp2f(-(float)f * (13.287712379549449f / 32.0f));
            const float ang = (float)(jj < 32 ? (pos >> 6) : (pos & 63)) * inv;
            COS[i] = __cosf(ang); SIN[i] = __sinf(ang); }
    }
    SEAM();
    if (PH_ON) { PHASE_PROLOG();
        pg8::Gemm g{WSP(bf16, WS_MEMB), WSP(bf16, WS_WMKV), MEMROWS, 4096, DM}; pg8::StaticOrder S; S.init(MEMROWS, 4096, G, bid);
        pg8::EpiBf16 E{WSP(bf16, WS_MKV), 4096, 1 << 30};
        pg8::gemm_phase<pg8::EpiBf16, pg8::StaticOrder, true, true>(ldsl, g, S, E);
    }
    SEAM();

    for (int j = 0; j < 2 * DEPTH; ++j) {
        const int l = j >> 1;
        if (PH_ON) { PHASE_PROLOG();
            pg8::Gemm g{WSP(bf16, WS_XB), WSP(bf16, WS_WGU + j * SZ_WGU), M, 2 * DFF, DM}; pg8::StaticOrder S; S.init(M, 2 * DFF, G, bid);
            pg8::EpiSwiGLU E{WSP(bf16, WS_H), DFF};
            pg8::gemm_phase<pg8::EpiSwiGLU, pg8::StaticOrder, true, true>(ldsl, g, S, E);
        }
        SEAM();
        if (PH_ON) { PHASE_PROLOG();
            pg8::Gemm g{WSP(bf16, WS_H), WSP(bf16, WS_WD + j * SZ_WD), M, DM, DFF}; pg8::StaticOrder S; S.init(M, DM, G, bid);
            pg8::EpiResid E{as_global(IN[19]), WSP(float, WS_Z), DM, ALPHA, 0.5f};
            pg8::gemm_phase<pg8::EpiResid, pg8::StaticOrder, true, true>(ldsl, g, S, E);
        }
        SEAM();
        if (PH_ON) { PHASE_PROLOG(); const int li = l * 4 + ((j & 1) ? 3 : 0); ln_phase(WSP(float, WS_Z), as_global((float*)IN[19]), WSP(bf16, WS_XB), as_global(IN[I_LNG]) + li * DM, as_global(IN[I_LNB]) + li * DM, gw, NGW, lane); }
        SEAM();
        if (!(j & 1)) {
            if (PH_ON) { PHASE_PROLOG();
                pg8::Gemm g{WSP(bf16, WS_XB), WSP(bf16, WS_WIN + l * SZ_WIN), M, INW, DM}; pg8::StaticOrder S; S.init(M, INW, G, bid);
                pg8::EpiBf16 E{WSP(bf16, WS_P), INW, C_GATE / 256};
                pg8::gemm_phase<pg8::EpiBf16, pg8::StaticOrder, true, true>(ldsl, g, S, E);
            }
            SEAM();
            if (PH_ON) { PHASE_PROLOG(); rope_phase(WSP(bf16, WS_P), as_global(IN[I_QKG]) + l * 256, as_global(IN[I_QKG]) + l * 256 + 128, WSP(float, WS_COS), WSP(float, WS_SIN), gw, NGW, lane); }
            SEAM();
            if (PH_ON) { PHASE_PROLOG();
                volatile LAS int* qs = (volatile LAS int*)(ldsl + att::OFF_Q);
                unsigned* qhead = WSP(unsigned, WS_CTL) + CW_Q + 64 * l;
                bf16* P = WSP(bf16, WS_P); float* O12 = WSP(float, WS_O12); bf16* YS = WSP(bf16, WS_YS); const float* BT = WSP(float, WS_BT);
                for (;;) {
                    if (tid == 0) *qs = (int)__hip_atomic_fetch_add(qhead, 1u, __ATOMIC_RELAXED, __HIP_MEMORY_SCOPE_AGENT);
                    __syncthreads();
                    const int u = __builtin_amdgcn_readfirstlane(*qs);
                    __syncthreads();
                    if (u >= 2048) break;
                    att::UnitP U; int row0, seq0, S_, q0;
                    U.mode = 0; U.tbl = BT; U.sink_l2 = -__builtin_inff(); U.obf = 1;
                    if (u < 1536) {
                        int t, prompt, dif;
                        if (u < 512) { t = u; prompt = 1; dif = 1; } else if (u < 768) { t = u - 512; prompt = 1; dif = 0; } else if (u < 1280) { t = u - 768; prompt = 0; dif = 1; } else { t = u - 1280; prompt = 0; dif = 0; }
                        const int qb = prompt ? (t & 15) : (t & 7); t >>= (prompt ? 4 : 3);
                        S_ = prompt ? 4096 : 2048; q0 = qb * 256;
                        if (dif) { const int vh = t & 1, m = (t >> 1) & 1, h = (t >> 2) & 3, b = t >> 4;
                            seq0 = prompt ? b * 4096 : 8192 + b * 2048; row0 = seq0 + q0;
                            U.Q = P + (size_t)row0 * INW + C_QA + (2 * h + m) * 128; U.K = P + (size_t)seq0 * INW + C_KA + (2 * h + m) * 128; U.V = P + (size_t)seq0 * INW + C_VA + (2 * h + vh) * 128;
                            U.O = O12 + (size_t)m * M * 1024 + (size_t)row0 * 1024 + (2 * h + vh) * 128; U.obf = 0; U.mode = 1; U.tbl = BT + h * att::TBL_PITCH;
                        } else { const int head = t & 7, b = t >> 3;
                            seq0 = prompt ? b * 4096 : 8192 + b * 2048; row0 = seq0 + q0;
                            U.Q = P + (size_t)row0 * INW + C_QC + head * 128; U.K = P + (size_t)seq0 * INW + C_KC + (head >> 2) * 128; U.V = P + (size_t)seq0 * INW + C_VC + (head >> 2) * 128;
                            U.O = YS + (size_t)2 * M * 1024 + (size_t)row0 * 1024 + head * 128; }
                        U.nt = S_ / 64; U.rel0 = -q0;
                    } else { const int t = u - 1536, head = t & 7, qbg = t >> 3;
                        if (qbg < 32) { S_ = 4096; seq0 = (qbg >> 4) * 4096; q0 = (qbg & 15) * 256; } else { S_ = 2048; seq0 = 8192 + ((qbg - 32) >> 3) * 2048; q0 = ((qbg - 32) & 7) * 256; }
                        row0 = seq0 + q0;
                        const int k0 = q0 >= 128 ? q0 - 128 : 0, k1 = (q0 + 384 < S_) ? q0 + 384 : S_;
                        U.Q = P + (size_t)row0 * INW + C_QB + head * 128; U.K = P + (size_t)(seq0 + k0) * INW + C_KB + (head >> 2) * 128; U.V = P + (size_t)(seq0 + k0) * INW + C_VB + (head >> 2) * 128;
                        U.O = YS + (size_t)1 * M * 1024 + (size_t)row0 * 1024 + head * 128; U.mode = 2; U.tbl = BT + (4 + head) * att::TBL_PITCH;
                        U.sink_l2 = ((const GAS float*)IN[I_SINK])[l * 8 + head] * 1.4426950408889634f;
                        U.nt = (k1 - k0) / 64; U.rel0 = k0 - q0; }
                    att::attn_unit<INW, INW, 1024, true>(U, (char*)lds);
                }
            }
            SEAM();
            if (PH_ON) { PHASE_PROLOG(); diffcomb_phase(WSP(float, WS_O12), WSP(bf16, WS_YS), as_global(IN[I_LAMQK]) + l * 512, as_global(IN[I_SUBG]) + l * 256, l, gw, NGW, lane); }
            SEAM();
            if (PH_ON) { PHASE_PROLOG();
                pg8::Gemm g{WSP(bf16, WS_YS), WSP(bf16, WS_WBR + l * SZ_WBR), 3 * M, 3 * DM, 1024}; pg8::BranchOrder S; S.init(G, bid);
                pg8::EpiBranch E{WSP(bf16, WS_P) + C_GATE, INW, WSP(bf16, WS_MG), DM};
                pg8::gemm_phase<pg8::EpiBranch, pg8::BranchOrder, true, true>(ldsl, g, S, E);
            }
            SEAM();
            if (PH_ON) { PHASE_PROLOG();
                pg8::Gemm g{WSP(bf16, WS_MG), WSP(bf16, WS_WOUT + l * SZ_WOUT), M, DM, DM}; pg8::StaticOrder S; S.init(M, DM, G, bid);
                pg8::EpiResid E{as_global(IN[19]), WSP(float, WS_Z), DM, ALPHA, 1.0f};
                pg8::gemm_phase<pg8::EpiResid, pg8::StaticOrder, true, true>(ldsl, g, S, E);
            }
            SEAM();
            if (PH_ON) { PHASE_PROLOG(); const int li = l * 4 + 1; ln_phase(WSP(float, WS_Z), as_global((float*)IN[19]), WSP(bf16, WS_XB), as_global(IN[I_LNG]) + li * DM, as_global(IN[I_LNB]) + li * DM, gw, NGW, lane); }
            SEAM();
            if (PH_ON) { PHASE_PROLOG();
                pg8::Gemm g{WSP(bf16, WS_XB), WSP(bf16, WS_WMQ + l * SZ_WMQ), M, MEMI, DM}; pg8::StaticOrder S; S.init(M, MEMI, G, bid);
                pg8::EpiBf16 E{WSP(bf16, WS_MQ), MEMI, 1 << 30};
                pg8::gemm_phase<pg8::EpiBf16, pg8::StaticOrder, true, true>(ldsl, g, S, E);
            }
            SEAM();
            if (PH_ON) { PHASE_PROLOG();
                bf16* MQ = WSP(bf16, WS_MQ); bf16* MKV = WSP(bf16, WS_MKV); bf16* MO = WSP(bf16, WS_MO);
                for (int u = bid; u < 256; u += G) { const int head = u & 3, qbg = u >> 2;
                    const int ms = qbg < 32 ? (qbg >> 4) : 2 + ((qbg - 32) >> 3);
                    att::UnitP U; U.mode = 0; U.tbl = nullptr; U.sink_l2 = -__builtin_inff(); U.obf = 1; U.nt = 4; U.rel0 = 0;
                    U.Q = MQ + (size_t)qbg * 256 * MEMI + head * 128; U.K = MKV + (size_t)ms * 256 * 4096 + l * 1024 + head * 128; U.V = U.K + 512;
                    U.O = MO + (size_t)qbg * 256 * MEMI + head * 128;
                    att::attn_unit<MEMI, 4096, MEMI, false>(U, (char*)lds);
                }
            }
            SEAM();
            if (PH_ON) { PHASE_PROLOG();
                pg8::Gemm g{WSP(bf16, WS_MO), WSP(bf16, WS_WMO + l * SZ_WMO), M, DM, MEMI}; pg8::StaticOrder S; S.init(M, DM, G, bid);
                pg8::EpiResid E{as_global(IN[19]), WSP(float, WS_Z), DM, ALPHA, 1.0f};
                pg8::gemm_phase<pg8::EpiResid, pg8::StaticOrder, true, true>(ldsl, g, S, E);
            }
            SEAM();
            if (PH_ON) { PHASE_PROLOG(); const int li = l * 4 + 2; ln_phase(WSP(float, WS_Z), as_global((float*)IN[19]), WSP(bf16, WS_XB), as_global(IN[I_LNG]) + li * DM, as_global(IN[I_LNB]) + li * DM, gw, NGW, lane); }
            SEAM();
        }
    }
#undef PH_ON
#undef SEAM
}
constexpr int N_PHASES = 2 + 8 * 3 + 4 * 11;

extern "C" void kernel_launch(void* const* d_in, const int* in_sizes, int n_in, void* d_out, int out_size, void* d_ws, size_t ws_size, hipStream_t stream) {
    static int grid = 0;
    if (grid == 0) {
        if (n_in != 19 || out_size != M * DM || ws_size < WS_END) { fprintf(stderr, "kernel_launch: unexpected shapes: n_in %d out %d ws %zu (need %zu)\n", n_in, out_size, ws_size, (size_t)WS_END); grid = -1; return; }
        int dev = 0, cus = 0, per_cu = 0;
        if (hipGetDevice(&dev) != hipSuccess || hipDeviceGetAttribute(&cus, hipDeviceAttributeMultiprocessorCount, dev) != hipSuccess) { fprintf(stderr, "kernel_launch: device query failed\n"); grid = -1; return; }
        if (hipFuncSetAttribute((const void*)fwd, hipFuncAttributeMaxDynamicSharedMemorySize, LDS_BYTES) != hipSuccess) { fprintf(stderr, "kernel_launch: hipFuncSetAttribute failed\n"); grid = -1; return; }
        if (hipOccupancyMaxActiveBlocksPerMultiprocessor(&per_cu, (const void*)fwd, NWAVES * 64, LDS_BYTES) != hipSuccess || per_cu < 1)
            fprintf(stderr, "kernel_launch: note: occupancy query reports %d workgroups per CU\n", per_cu);
        (void)hipGetLastError();
        grid = cus;
    }
    if (grid < 0) return;
    if (hipMemsetAsync((char*)d_ws + WS_CTL, 0, CTL_ZERO_BYTES, stream) != hipSuccess) { fprintf(stderr, "kernel_launch: memset failed\n"); return; }
    Args a{};
    for (int i = 0; i < 19; ++i) a.in[i] = (const float*)d_in[i];
    a.out = (float*)d_out; a.ws = (unsigned char*)d_ws; a.pad = 0;
#if MK_ONE_LAUNCH
    a.ph_lo = 0; a.ph_hi = N_PHASES; a.li = 0;
    hipLaunchKernelGGL(fwd, dim3(grid), dim3(NWAVES * 64), LDS_BYTES, stream, a);
#else
    for (int p = 0; p < N_PHASES; ++p) { a.ph_lo = p; a.ph_hi = p + 1; a.li = 0;
        hipLaunchKernelGGL(fwd, dim3(grid), dim3(NWAVES * 64), LDS_BYTES, stream, a); }
#endif
    const hipError_t le = hipPeekAtLastError();
    if (le != hipSuccess) fprintf(stderr, "kernel_launch: launch failed: %s\n", hipGetErrorName(le));
}
```
